# Optimizing an MI355X kernel written in HIP

```python
import jax, jax.numpy as jnp
from jax import lax
import numpy as np

D_MODEL = 1024
BATCH = 16
SEQ = 2048
DEPTH = 1
DEC_BATCH = 32
DEC_SEQ = 2048
PAST_LEN = 128

GRID_W = 64
MIX_W = D_MODEL
NA_HEADS = 8
NA_HEAD_DIM = 64
NA_WIN_ROWS = 8
NA_WIN_COLS = 16
NA_QBLOCK_COLS = 16
GDN_HEADS = 4
GDN_DK = 128
GDN_DV = 128
GDN_CONV = 5
GDN_CHUNK = 64
D_FF = 2816
FFN_CONV = 3
LN_EPS = 1e-5
RMS_EPS = 1e-6
DEEPNORM_ALPHA = (2 * DEPTH) ** 0.25
DEEPNORM_BETA = (8 * DEPTH) ** -0.25

NA_WIDTH = NA_HEADS * NA_HEAD_DIM
GDN_QK_WIDTH = GDN_HEADS * GDN_DK
GDN_V_WIDTH = GDN_HEADS * GDN_DV
GDN_CONV_CH = 2 * GDN_QK_WIDTH + GDN_V_WIDTH
IN_SPLITS = (NA_WIDTH, NA_WIDTH, NA_WIDTH, GDN_QK_WIDTH, GDN_QK_WIDTH, GDN_V_WIDTH, GDN_V_WIDTH,
             GDN_HEADS, GDN_HEADS, GDN_HEADS, GDN_HEADS)
IN_COLS = sum(IN_SPLITS)

kernel_name = 'hymba_natten_gdn_encoder'


def _layer_norm(x, g, b):
    xf = x.astype(jnp.float32)
    mu = jnp.mean(xf, -1, keepdims=True)
    var = jnp.mean(jnp.square(xf - mu), -1, keepdims=True)
    y = (xf - mu) * lax.rsqrt(var + LN_EPS) * g.astype(jnp.float32) + b.astype(jnp.float32)
    return y.astype(x.dtype)


def _l2norm(t):
    return t * lax.rsqrt(jnp.sum(t * t, -1, keepdims=True) + RMS_EPS)


def _dwconv_centred(x, w):
    k = w.shape[0]
    pad = k // 2
    s = x.shape[1]
    xp = jnp.pad(x, ((0, 0), (pad, pad), (0, 0)))
    y = xp[:, 0:s] * w[0]
    for j in range(1, k):
        y = y + xp[:, j:j + s] * w[j]
    return y


def _na_col_tables():
    ncb = GRID_W // NA_QBLOCK_COLS
    span = NA_QBLOCK_COLS + NA_WIN_COLS
    kc0 = np.clip(np.arange(ncb) * NA_QBLOCK_COLS - NA_WIN_COLS // 2, 0, GRID_W - span)
    kcols = kc0[:, None] + np.arange(span)
    qcols = np.arange(GRID_W).reshape(ncb, NA_QBLOCK_COLS)
    start = np.clip(qcols - NA_WIN_COLS // 2, 0, GRID_W - NA_WIN_COLS)
    kc = kcols[:, None, :]
    colmask = (kc >= start[..., None]) & (kc < start[..., None] + NA_WIN_COLS)
    dc_idx = np.clip(kc - qcols[..., None] + NA_WIN_COLS - 1, 0, 2 * NA_WIN_COLS - 2)
    return kcols, colmask, dc_idx


def _neighbourhood_attention(q, k, v, rpb):
    b, h, rows, w, hd = q.shape
    wr = min(NA_WIN_ROWS, rows)
    kcols, colmask, dc_idx = _na_col_tables()
    ncb, span = kcols.shape
    bias_c = rpb[:, :, dc_idx].astype(jnp.float32)
    colmask_b = jnp.asarray(colmask)[:, :, None, :]

    def row(r):
        rs = jnp.clip(r - wr // 2, 0, rows - wr)
        qr = lax.dynamic_index_in_dim(q, r, axis=2, keepdims=False).reshape(b, h, ncb, NA_QBLOCK_COLS, hd)
        kr = lax.dynamic_slice_in_dim(k, rs, wr, axis=2)[:, :, :, kcols]
        vr = lax.dynamic_slice_in_dim(v, rs, wr, axis=2)[:, :, :, kcols]
        s = jnp.einsum('bhnqd,bhrnkd->bhnqrk', qr, kr).astype(jnp.float32)
        dr_idx = rs + jnp.arange(wr) - r + (NA_WIN_ROWS - 1)
        bias = jnp.take(bias_c, dr_idx, axis=1).transpose(0, 2, 3, 1, 4)
        s = jnp.where(colmask_b, s + bias, -1e30)
        p = jax.nn.softmax(s.reshape(b, h, ncb, NA_QBLOCK_COLS, wr * span), axis=-1)
        p = p.reshape(s.shape).astype(v.dtype)
        o = jnp.einsum('bhnqrk,bhrnkd->bhnqd', p, vr)
        return o.reshape(b, h, w, hd)

    out = lax.map(row, jnp.arange(rows))
    return out.transpose(1, 0, 3, 2, 4).reshape(b, rows * w, h * hd)


def _gated_delta_chunked(q, k, v, beta, g):
    b, s, h, dk = q.shape
    dv = v.shape[-1]
    c = GDN_CHUNK
    n = s // c
    chunks = lambda t: t.reshape(b, n, c, h, -1).transpose(0, 3, 1, 2, 4)
    q, k, v = chunks(q), chunks(k), chunks(v)
    beta = beta.reshape(b, n, c, h).transpose(0, 3, 1, 2)
    g = g.reshape(b, n, c, h).transpose(0, 3, 1, 2)
    gc = jnp.cumsum(g, axis=-1)
    tril = jnp.asarray(np.tril(np.ones((c, c), dtype=bool)))
    strict = jnp.asarray(np.tril(np.ones((c, c), dtype=bool), -1))
    decay = jnp.exp(jnp.where(tril, gc[..., :, None] - gc[..., None, :], -jnp.inf))
    kb = k * beta[..., None]
    lower = jnp.where(strict, jnp.einsum('bhnid,bhnjd->bhnij', kb, k) * decay, 0.0)
    a = lower + jnp.eye(c, dtype=jnp.float32)
    rhs = jnp.concatenate([v * beta[..., None], kb * jnp.exp(gc)[..., None]], axis=-1)
    sol = lax.linalg.triangular_solve(a, rhs, left_side=True, lower=True, unit_diagonal=True)
    u, wk = sol[..., :dv], sol[..., dv:]
    attn = jnp.einsum('bhnid,bhnjd->bhnij', q, k) * decay
    q_dec = q * jnp.exp(gc)[..., None]
    k_dec = k * jnp.exp(gc[..., -1:] - gc)[..., None]
    chunk_decay = jnp.exp(gc[..., -1])
    xs = tuple(jnp.moveaxis(t, 2, 0) for t in (u, wk, attn, q_dec, k_dec, chunk_decay))

    def step(state, inp):
        u_i, w_i, attn_i, qd_i, kd_i, cd_i = inp
        v_new = u_i - jnp.einsum('bhcd,bhde->bhce', w_i, state)
        o = jnp.einsum('bhcd,bhde->bhce', qd_i, state) + jnp.einsum('bhij,bhje->bhie', attn_i, v_new)
        state = state * cd_i[..., None, None] + jnp.einsum('bhcd,bhce->bhde', kd_i, v_new)
        return state, o

    state0 = jnp.zeros((b, h, dk, dv), jnp.float32)
    _, o = lax.scan(step, state0, xs)
    return o.transpose(1, 0, 3, 2, 4).reshape(b, s, h, dv)


def _layer(x, w_in, na_rpb, gdn_conv_w, gdn_a_log, gdn_dt_bias, gdn_norm_w, w_out,
           ln1_g, ln1_b, ffn_w_up, ffn_conv_w, ffn_conv_b, ffn_w_down, ln2_g, ln2_b):
    b, s, _ = x.shape
    rows = s // GRID_W
    f32 = jnp.float32
    proj = x @ w_in
    na_q, na_k, na_v, g_q, g_k, g_v, g_z, bf, bb, af, ab = jnp.split(
        proj, np.cumsum(IN_SPLITS)[:-1].tolist(), axis=-1)
    grid = lambda t: t.reshape(b, rows, GRID_W, NA_HEADS, NA_HEAD_DIM).transpose(0, 3, 1, 2, 4)
    na_out = _neighbourhood_attention(grid(na_q * NA_HEAD_DIM ** -0.5), grid(na_k), grid(na_v), na_rpb)
    qkv = jax.nn.silu(_dwconv_centred(jnp.concatenate([g_q, g_k, g_v], -1), gdn_conv_w)).astype(f32)
    gq, gk, gv = jnp.split(qkv, [GDN_QK_WIDTH, 2 * GDN_QK_WIDTH], axis=-1)
    heads = lambda t: t.reshape(b, s, GDN_HEADS, -1)
    gq = _l2norm(heads(gq)) * GDN_DK ** -0.5
    gk = _l2norm(heads(gk))
    gv = heads(gv)
    a_log = gdn_a_log.astype(f32)
    dt_bias = gdn_dt_bias.astype(f32)
    beta_f = jax.nn.sigmoid(bf.astype(f32))
    beta_b = jax.nn.sigmoid(bb.astype(f32))
    g_f = -jnp.exp(a_log[0]) * jax.nn.softplus(af.astype(f32) + dt_bias[0])
    g_b = -jnp.exp(a_log[1]) * jax.nn.softplus(ab.astype(f32) + dt_bias[1])
    flip = lambda t: jnp.flip(t, axis=1)
    o_f = _gated_delta_chunked(gq, gk, gv, beta_f, g_f)
    o_b = flip(_gated_delta_chunked(flip(gq), flip(gk), flip(gv), flip(beta_b), flip(g_b)))
    o = o_f + o_b
    o = o * lax.rsqrt(jnp.mean(o * o, -1, keepdims=True) + RMS_EPS) * gdn_norm_w.astype(f32) \
        * jax.nn.silu(heads(g_z).astype(f32))
    gdn_out = o.reshape(b, s, GDN_V_WIDTH).astype(x.dtype)
    mix = jnp.concatenate([na_out, gdn_out], axis=-1) @ w_out
    x = _layer_norm(DEEPNORM_ALPHA * x + mix, ln1_g, ln1_b)
    hdn = _dwconv_centred(x @ ffn_w_up, ffn_conv_w) + ffn_conv_b
    gate, val = jnp.split(hdn, 2, axis=-1)
    ffn = (jax.nn.silu(gate) * val) @ ffn_w_down
    return _layer_norm(DEEPNORM_ALPHA * x + ffn, ln2_g, ln2_b)


def _trunk(x, w_in, na_rpb, gdn_conv_w, gdn_a_log, gdn_dt_bias, gdn_norm_w, w_out,
           ln1_g, ln1_b, ffn_w_up, ffn_conv_w, ffn_conv_b, ffn_w_down, ln2_g, ln2_b):
    for l in range(DEPTH):
        x = _layer(x, w_in[l], na_rpb[l], gdn_conv_w[l], gdn_a_log[l], gdn_dt_bias[l], gdn_norm_w[l],
                   w_out[l], ln1_g[l], ln1_b[l], ffn_w_up[l], ffn_conv_w[l], ffn_conv_b[l],
                   ffn_w_down[l], ln2_g[l], ln2_b[l])
    return x


def setup_inputs(seed: int = 0) -> dict:
    key = jax.random.key(seed)
    ks = jax.random.split(key, 20)
    nrm = lambda k, shp: jax.random.normal(k, shp, jnp.float32)
    x_prompt = nrm(ks[0], (BATCH, SEQ, D_MODEL))
    x_sample = nrm(ks[1], (DEC_BATCH, DEC_SEQ, D_MODEL))
    col_scale = np.ones((IN_COLS,), np.float32)
    offs = np.concatenate([[0], np.cumsum(IN_SPLITS)])
    col_scale[offs[2]:offs[3]] = DEEPNORM_BETA
    col_scale[offs[5]:offs[6]] = DEEPNORM_BETA
    w_in = nrm(ks[2], (DEPTH, D_MODEL, IN_COLS)) * D_MODEL ** -0.5 * jnp.asarray(col_scale)
    na_rpb = 0.02 * nrm(ks[3], (DEPTH, NA_HEADS, 2 * NA_WIN_ROWS - 1, 2 * NA_WIN_COLS - 1))
    gdn_conv_w = nrm(ks[4], (DEPTH, GDN_CONV, GDN_CONV_CH)) * GDN_CONV ** -0.5
    gdn_a_log = jnp.log(jax.random.uniform(ks[5], (DEPTH, 2, GDN_HEADS), jnp.float32, 1.0, 16.0))
    dt = jnp.exp(jax.random.uniform(ks[6], (DEPTH, 2, GDN_HEADS), jnp.float32,
                                    float(np.log(1e-3)), float(np.log(0.1))))
    gdn_dt_bias = dt + jnp.log(-jnp.expm1(-dt))
    gdn_norm_w = 1.0 + 0.02 * nrm(ks[7], (DEPTH, GDN_DV))
    w_out = nrm(ks[8], (DEPTH, MIX_W, D_MODEL)) * MIX_W ** -0.5 * DEEPNORM_BETA
    ln1_g = 1.0 + 0.02 * nrm(ks[9], (DEPTH, D_MODEL))
    ln1_b = 0.02 * nrm(ks[10], (DEPTH, D_MODEL))
    ffn_w_up = nrm(ks[11], (DEPTH, D_MODEL, 2 * D_FF)) * D_MODEL ** -0.5 * DEEPNORM_BETA
    ffn_conv_w = nrm(ks[12], (DEPTH, FFN_CONV, 2 * D_FF)) * FFN_CONV ** -0.5
    ffn_conv_b = 0.02 * nrm(ks[13], (DEPTH, 2 * D_FF))
    ffn_w_down = nrm(ks[14], (DEPTH, D_FF, D_MODEL)) * D_FF ** -0.5 * DEEPNORM_BETA
    ln2_g = 1.0 + 0.02 * nrm(ks[15], (DEPTH, D_MODEL))
    ln2_b = 0.02 * nrm(ks[16], (DEPTH, D_MODEL))
    return {'x_prompt': x_prompt, 'x_sample': x_sample, 'w_in': w_in, 'na_rpb': na_rpb,
            'gdn_conv_w': gdn_conv_w, 'gdn_a_log': gdn_a_log, 'gdn_dt_bias': gdn_dt_bias,
            'gdn_norm_w': gdn_norm_w, 'w_out': w_out, 'ln1_g': ln1_g, 'ln1_b': ln1_b,
            'ffn_w_up': ffn_w_up, 'ffn_conv_w': ffn_conv_w, 'ffn_conv_b': ffn_conv_b,
            'ffn_w_down': ffn_w_down, 'ln2_g': ln2_g, 'ln2_b': ln2_b}


def reference(x_prompt, x_sample, w_in, na_rpb, gdn_conv_w, gdn_a_log, gdn_dt_bias, gdn_norm_w,
              w_out, ln1_g, ln1_b, ffn_w_up, ffn_conv_w, ffn_conv_b, ffn_w_down, ln2_g, ln2_b):
    y_prompt = _trunk(x_prompt, w_in, na_rpb, gdn_conv_w, gdn_a_log, gdn_dt_bias, gdn_norm_w, w_out,
                      ln1_g, ln1_b, ffn_w_up, ffn_conv_w, ffn_conv_b, ffn_w_down, ln2_g, ln2_b)
    y_sample = _trunk(x_sample, w_in, na_rpb, gdn_conv_w, gdn_a_log, gdn_dt_bias, gdn_norm_w, w_out,
                      ln1_g, ln1_b, ffn_w_up, ffn_conv_w, ffn_conv_b, ffn_w_down, ln2_g, ln2_b)
    return (y_prompt, y_sample)
```

```cpp
#include <hip/hip_runtime.h>
#include <hip/hip_cooperative_groups.h>
#include <cstdio>
namespace cg = cooperative_groups;

#define LAS __attribute__((address_space(3)))
typedef unsigned short bf16_t;
typedef short bf16x8 __attribute__((ext_vector_type(8)));
typedef float f32x4 __attribute__((ext_vector_type(4)));
typedef unsigned u32x4 __attribute__((ext_vector_type(4)));
typedef unsigned u32x2 __attribute__((ext_vector_type(2)));

#ifndef ONE_LAUNCH
#define ONE_LAUNCH 1
#endif

constexpr int T_TOK = 98304, T_PROMPT = 32768, SEQL = 2048;
constexpr size_t MiB = (size_t)1 << 20;
constexpr size_t OFF_WMAIN = 0, OFF_WV = 6 * MiB, OFF_WG = 7 * MiB, OFF_WOUT = 8 * MiB, OFF_WUP = 10 * MiB, OFF_WDOWN = 21 * MiB, OFF_CD = 27 * MiB,
                 OFF_XB = 28 * MiB, OFF_MIX = 28 * MiB, OFF_SEG = 220 * MiB, OFF_NA2 = 508 * MiB, OFF_VT = 700 * MiB, OFF_PREP = 508 * MiB, OFF_H1 = 220 * MiB,
                 OFF_X1 = 604 * MiB, OFF_FFNB = 796 * MiB, OFF_HDN = 28 * MiB, OFF_ACT = 380 * MiB, WS_NEED = 1024 * MiB;
constexpr size_t SEG_ELEMS = (size_t)T_TOK * 512;
constexpr size_t OOFF_O = 0, OOFF_GATES = 192 * MiB, OOFF_Z = 198 * MiB;
constexpr int PREP_ITEM = 73728;
constexpr int PI_W = 0, PI_QD = 16384, PI_ATTN = 32768, PI_KDT = 40960, PI_UT = 57344;
constexpr int LDS_BAR_OFF = 155648, LDS_BYTES = LDS_BAR_OFF + 16;
constexpr size_t OFF_BAR = 27 * MiB + 512 * 1024;
constexpr float DN_ALPHA = 1.189207115002721f;

struct Params {
    const float* xp; const float* xs; const float* w_in; const float* rpb; const float* gconv; const float* a_log; const float* dt_bias; const float* gnorm;
    const float* w_out; const float* ln1g; const float* ln1b; const float* w_up; const float* fconvw; const float* fconvb; const float* w_down;
    const float* ln2g; const float* ln2b; float* out; unsigned char* ws;
};

__device__ __forceinline__ int opaque_tid() { int t = threadIdx.x; asm volatile("" : "+v"(t)); return t; }
typedef float f32x2_t __attribute__((ext_vector_type(2)));
typedef __bf16 bf16x2_t __attribute__((ext_vector_type(2)));
__device__ __forceinline__ unsigned cvt_pk_bf16(float lo, float hi) { const f32x2_t v = {lo, hi}; union { bf16x2_t b; unsigned u; } c; c.b = __builtin_convertvector(v, bf16x2_t); return c.u; }
__device__ __forceinline__ float bflo(unsigned u) { return __uint_as_float(u << 16); }
__device__ __forceinline__ float bfhi(unsigned u) { return __uint_as_float(u & 0xffff0000u); }
__device__ __forceinline__ float bf2f(bf16_t b) { return __uint_as_float(((unsigned)b) << 16); }
__device__ __forceinline__ bf16_t f2bf(float f) { return (bf16_t)(cvt_pk_bf16(f, 0.f) & 0xffffu); }
__device__ __forceinline__ float silu_f(float x) { return x * __builtin_amdgcn_rcpf(1.f + __expf(-x)); }
__device__ __forceinline__ float sigmoid_f(float x) { return __builtin_amdgcn_rcpf(1.f + __expf(-x)); }
__device__ __forceinline__ const float* xrow(const Params& p, int row) { return row < T_PROMPT ? p.xp + (size_t)row * 1024 : p.xs + (size_t)(row - T_PROMPT) * 1024; }
__device__ __forceinline__ bf16x8 as_bf16x8(u32x4 v) { union { u32x4 u; bf16x8 b; } c; c.u = v; return c.b; }
__device__ __forceinline__ int perm_k(int c) { return (c & ~31) | (((c >> 2) & 3) << 3) | (((c >> 4) & 1) << 2) | (c & 3); }

namespace pg8 {
constexpr int BM = 256, BK = 64, HALF = 128, HTB = HALF * BK * 2, STAGE_BYTES = 8 * HTB, NXCD = 8, WGM = 8;
__host__ __device__ __forceinline__ int lds_byte(int r, int c) { const int st = (r >> 4) * 2 + (c >> 5), rr = r & 15, cc = c & 31, ob = rr * 64 + cc * 2; return st * 1024 + (ob ^ (((ob >> 9) & 1) << 5)); }
__host__ __device__ __forceinline__ void stage_rc(int b, int& R, int& C) { const int st = b / 1024, sb = b % 1024, swz = sb ^ (((sb >> 9) & 1) << 5); R = (st >> 1) * 16 + swz / 64; C = (st & 1) * 32 + (swz % 64) / 2; }
__host__ __device__ __forceinline__ int perm32(int rho) { const int n = rho >> 4, i = rho & 15; return 8 * (i >> 2) + 4 * n + (i & 3); }
struct Unit { int pm, pn; };
struct Gemm { const bf16_t* A; const bf16_t* Bt; int M, N, K; };
struct StaticOrder {
    int nM, nN, nwg, G, c;
    __device__ void init(int M, int N, int G_, int c_) { nM = M / BM; nN = N / BM; nwg = nM * nN; G = G_; c = c_; }
    __device__ bool next(int i, Unit& u) const {
        const long L = (long)i * G + c; if (L >= nwg) return false;
        int wgid = (int)L; { const int q = nwg / NXCD, r = nwg % NXCD, xcd = wgid % NXCD, off = wgid / NXCD; wgid = (xcd < r ? xcd * (q + 1) : r * (q + 1) + (xcd - r) * q) + off; }
        const int nig = WGM * nN, gid = wgid / nig, fm = gid * WGM, gsz = (nM - fm) < WGM ? (nM - fm) : WGM;
        u.pm = fm + ((wgid % nig) % gsz); u.pn = (wgid % nig) / gsz; return true;
    }
};

template <class Epi>
__device__ __forceinline__ void gemm_phase(LAS unsigned char* lds, const Gemm g, const StaticOrder& S, const Epi& E) {
    const int tid = opaque_tid(), wid = __builtin_amdgcn_readfirstlane(tid >> 6), lane = tid & 63, wr = wid >> 2, wc = wid & 3, fr = lane & 15, fq = lane >> 4;
    const int K = g.K, nt = K / BK;
    unsigned voffA[2], voffB[2];
#pragma unroll
    for (int i = 0; i < 2; ++i) { int R, C; stage_rc(tid * 16 + i * 8192, R, C); const int Rb = Epi::PERM ? ((R & ~31) + perm32(R & 31)) : R;
        voffA[i] = (unsigned)(R * K + C) * 2u; voffB[i] = (unsigned)(Rb * K + C) * 2u; }
    const size_t kstep = (size_t)(BK * 2);
    const size_t hstep = (size_t)HALF * K * 2;
    const size_t tstep = 2 * hstep;
    const unsigned ldsw = (unsigned)wid * 1024u;
    const int aoff = lds_byte(wr * 64 + fr, fq * 8), boff = lds_byte(wc * 32 + fr, fq * 8);
#define PG8_SA(b, h) (((b) * 2 + (h)) * HTB)
#define PG8_SB(b, h) ((4 + (b) * 2 + (h)) * HTB)
#define PG8_STAGE(bufoff, gbase, voff) do { _Pragma("unroll") for (int _i = 0; _i < 2; ++_i) \
        __builtin_amdgcn_global_load_lds((const unsigned*)((const char*)(gbase) + (voff)[_i]), (LAS unsigned*)(lds + (bufoff) + ldsw + _i * 8192), 16, 0, 0); } while (0)
#define PG8_LDA(dst, b, h) do { _Pragma("unroll") for (int m = 0; m < 4; ++m) _Pragma("unroll") for (int k = 0; k < 2; ++k) dst[m][k] = *(const LAS bf16x8*)(lds + PG8_SA(b, h) + aoff + m * 2048 + k * 1024); } while (0)
#define PG8_LDB(dst, b, h) do { _Pragma("unroll") for (int n = 0; n < 2; ++n) _Pragma("unroll") for (int k = 0; k < 2; ++k) dst[n][k] = *(const LAS bf16x8*)(lds + PG8_SB(b, h) + boff + n * 2048 + k * 1024); } while (0)
#define PG8_MMA(ai, bj, At, Bt) do { __builtin_amdgcn_s_setprio(1); _Pragma("unroll") for (int m = 0; m < 4; ++m) _Pragma("unroll") for (int n = 0; n < 2; ++n) _Pragma("unroll") for (int k = 0; k < 2; ++k) \
        acc[ai][bj][m][n] = __builtin_amdgcn_mfma_f32_16x16x32_bf16(Bt[n][k], At[m][k], acc[ai][bj][m][n], 0, 0, 0); __builtin_amdgcn_s_setprio(0); } while (0)
#define PG8_WAIT_V(n) asm volatile("s_waitcnt vmcnt(" #n ")" ::: "memory")
#define PG8_WAIT_L(n) asm volatile("s_waitcnt lgkmcnt(" #n ")" ::: "memory")
#define PG8_BAR __builtin_amdgcn_s_barrier()
#define PG8_SCHED __builtin_amdgcn_sched_barrier(0)
    Unit cur, nxt; int ui = 0;
    if (!S.next(0, cur)) return;
    f32x4 acc[2][2][4][2];
#pragma unroll
    for (int a = 0; a < 2; ++a)
#pragma unroll
        for (int b = 0; b < 2; ++b)
#pragma unroll
            for (int m = 0; m < 4; ++m)
#pragma unroll
                for (int n = 0; n < 2; ++n) acc[a][b][m][n] = (f32x4){0.f, 0.f, 0.f, 0.f};
    bf16x8 At[4][2], B0[2][2], B1[2][2];
    const char* cA = (const char*)g.A + (size_t)cur.pm * tstep; const char* cB = (const char*)g.Bt + (size_t)cur.pn * tstep;
    PG8_STAGE(PG8_SB(0, 0), cB, voffB); PG8_STAGE(PG8_SA(0, 0), cA, voffA); PG8_STAGE(PG8_SB(0, 1), cB + hstep, voffB); PG8_STAGE(PG8_SA(0, 1), cA + hstep, voffA);
    if (wr == 1) PG8_BAR;
    PG8_WAIT_V(4); PG8_BAR;
    PG8_STAGE(PG8_SB(1, 0), cB + kstep, voffB); PG8_STAGE(PG8_SA(1, 0), cA + kstep, voffA); PG8_STAGE(PG8_SB(1, 1), cB + hstep + kstep, voffB);
    PG8_WAIT_V(6); PG8_BAR;
    for (;;) {
        const bool has_next = S.next(ui + 1, nxt);
        const char* nA = has_next ? (const char*)g.A + (size_t)nxt.pm * tstep : cA; const char* nB = has_next ? (const char*)g.Bt + (size_t)nxt.pn * tstep : cB;
        for (int t = 0; t < nt; t += 2) {
            const bool last = (t == nt - 2);
            const char* a1 = cA + (size_t)(t + 1) * kstep;
            const char* a2 = last ? nA : cA + (size_t)(t + 2) * kstep; const char* b2 = last ? nB : cB + (size_t)(t + 2) * kstep;
            const char* a3 = a2 + kstep; const char* b3 = b2 + kstep;
            PG8_LDB(B0, 0, 0); PG8_SCHED; PG8_LDA(At, 0, 0); PG8_STAGE(PG8_SA(1, 1), a1 + hstep, voffA);
            PG8_WAIT_L(8); PG8_BAR; PG8_WAIT_L(0); PG8_MMA(0, 0, At, B0); PG8_BAR; PG8_SCHED;
            PG8_LDB(B1, 0, 1); PG8_STAGE(PG8_SB(0, 0), b2, voffB);
            PG8_BAR; PG8_WAIT_L(0); PG8_MMA(0, 1, At, B1); PG8_BAR;
            PG8_LDA(At, 0, 1); PG8_STAGE(PG8_SA(0, 0), a2, voffA);
            PG8_BAR; PG8_WAIT_L(0); PG8_MMA(1, 0, At, B0); PG8_BAR; PG8_SCHED;
            PG8_STAGE(PG8_SB(0, 1), b2 + hstep, voffB);
            PG8_WAIT_V(6); PG8_BAR; PG8_MMA(1, 1, At, B1); PG8_BAR;
            PG8_LDB(B0, 1, 0); PG8_SCHED; PG8_LDA(At, 1, 0); PG8_STAGE(PG8_SA(0, 1), a2 + hstep, voffA);
            PG8_WAIT_L(8); PG8_BAR; PG8_WAIT_L(0); PG8_MMA(0, 0, At, B0); PG8_BAR; PG8_SCHED;
            PG8_LDB(B1, 1, 1); PG8_STAGE(PG8_SB(1, 0), b3, voffB);
            PG8_BAR; PG8_WAIT_L(0); PG8_MMA(0, 1, At, B1); PG8_BAR;
            PG8_LDA(At, 1, 1); PG8_STAGE(PG8_SA(1, 0), a3, voffA);
            PG8_BAR; PG8_WAIT_L(0); PG8_MMA(1, 0, At, B0); PG8_BAR; PG8_SCHED;
            PG8_STAGE(PG8_SB(1, 1), b3 + hstep, voffB);
            PG8_WAIT_V(6); PG8_BAR; PG8_MMA(1, 1, At, B1); PG8_BAR;
        }
        E(acc, cur, wr, wc, fr, fq);
        if (!has_next) break;
#pragma unroll
        for (int a = 0; a < 2; ++a)
#pragma unroll
            for (int b = 0; b < 2; ++b)
#pragma unroll
                for (int m = 0; m < 4; ++m)
#pragma unroll
                    for (int n = 0; n < 2; ++n) acc[a][b][m][n] = (f32x4){0.f, 0.f, 0.f, 0.f};
        cur = nxt; cA = nA; cB = nB; ++ui;
    }
    PG8_WAIT_V(0);
    if (wr == 0) PG8_BAR;
    PG8_BAR;
#undef PG8_SA
#undef PG8_SB
#undef PG8_STAGE
#undef PG8_LDA
#undef PG8_LDB
#undef PG8_MMA
#undef PG8_WAIT_V
#undef PG8_WAIT_L
#undef PG8_BAR
#undef PG8_SCHED
}

struct EpiBf16 {
    static constexpr bool PERM = true;
    bf16_t* O; int ldc;
    __device__ __forceinline__ void operator()(const f32x4 (&acc)[2][2][4][2], const Unit& u, int wr, int wc, int fr, int fq) const {
        const int row0 = u.pm * BM + wr * 64 + fr, col0 = u.pn * BM + wc * 32 + 8 * fq; bf16_t* base = O;
#pragma unroll
        for (int ai = 0; ai < 2; ++ai)
#pragma unroll
            for (int m = 0; m < 4; ++m) { bf16_t* rowp = base + (size_t)(row0 + ai * HALF + m * 16) * ldc + col0;
#pragma unroll
                for (int bj = 0; bj < 2; ++bj) { const f32x4 v0 = acc[ai][bj][m][0], v1 = acc[ai][bj][m][1];
                    u32x4 w; w.x = cvt_pk_bf16(v0[0], v0[1]); w.y = cvt_pk_bf16(v0[2], v0[3]); w.z = cvt_pk_bf16(v1[0], v1[1]); w.w = cvt_pk_bf16(v1[2], v1[3]);
                    *(u32x4*)(rowp + bj * HALF) = w; } }
    }
};
struct EpiNAqk {
    static constexpr bool PERM = true;
    bf16_t* O;
    __device__ __forceinline__ void operator()(const f32x4 (&acc)[2][2][4][2], const Unit& u, int wr, int wc, int fr, int fq) const {
        const int row0 = u.pm * BM + wr * 64 + fr;
#pragma unroll
        for (int ai = 0; ai < 2; ++ai)
#pragma unroll
            for (int m = 0; m < 4; ++m) { const int tok = row0 + ai * HALF + m * 16;
#pragma unroll
                for (int bj = 0; bj < 2; ++bj) { const int hh = u.pn * 4 + bj * 2 + (wc >> 1);
                    bf16_t* dst = O + (size_t)hh * ((size_t)T_TOK * 64) + (size_t)(tok >> 3) * 512 + (wc & 1) * 256 + (tok & 7) * 32 + fq * 8;
                    const f32x4 v0 = acc[ai][bj][m][0], v1 = acc[ai][bj][m][1];
                    u32x4 w; w.x = cvt_pk_bf16(v0[0], v0[1]); w.y = cvt_pk_bf16(v0[2], v0[3]); w.z = cvt_pk_bf16(v1[0], v1[1]); w.w = cvt_pk_bf16(v1[2], v1[3]);
                    *(u32x4*)dst = w; } }
    }
};
struct EpiVT {
    static constexpr bool PERM = true;
    bf16_t* O;
    __device__ __forceinline__ void operator()(const f32x4 (&acc)[2][2][4][2], const Unit& u, int wr, int wc, int fr, int fq) const {
        const int row0 = u.pm * BM + wr * 64 + fr, col0 = u.pn * BM + wc * 32 + 8 * fq;
#pragma unroll
        for (int ai = 0; ai < 2; ++ai)
#pragma unroll
            for (int m = 0; m < 4; ++m) { const int f = row0 + ai * HALF + m * 16;
                bf16_t* fb = O + (size_t)(f >> 6) * ((size_t)T_TOK * 64) + (f & 63) * 4;
#pragma unroll
                for (int bj = 0; bj < 2; ++bj)
#pragma unroll
                    for (int n = 0; n < 2; ++n) { const f32x4 v = acc[ai][bj][m][n];
                        u32x2 w; w.x = cvt_pk_bf16(v[0], v[1]); w.y = cvt_pk_bf16(v[2], v[3]);
                        *(u32x2*)(fb + (size_t)(((col0 + bj * HALF) >> 2) + n) * 256) = w; } }
    }
};
template <bool RES_BF16> struct EpiRes {
    static constexpr bool PERM = false;
    float* C; const void* res0; const void* res1; int split_row; float alpha;
    __device__ __forceinline__ void operator()(const f32x4 (&acc)[2][2][4][2], const Unit& u, int wr, int wc, int fr, int fq) const {
        const int row0 = u.pm * BM + wr * 64 + fr, col0 = u.pn * BM + wc * 32 + 4 * fq;
#pragma unroll
        for (int ai = 0; ai < 2; ++ai)
#pragma unroll
            for (int m = 0; m < 4; ++m) { const int row = row0 + ai * HALF + m * 16; float* rowp = C + (size_t)row * 1024 + col0;
                const size_t roff = (row < split_row) ? (size_t)row * 1024 : (size_t)(row - split_row) * 1024; const void* rb = (row < split_row) ? res0 : res1;
#pragma unroll
                for (int bj = 0; bj < 2; ++bj)
#pragma unroll
                    for (int n = 0; n < 2; ++n) { const int co = bj * HALF + n * 16; f32x4 r;
                        if (RES_BF16) { const u32x2 rv = *(const u32x2*)((const bf16_t*)rb + roff + col0 + co); r = (f32x4){bflo(rv.x), bfhi(rv.x), bflo(rv.y), bfhi(rv.y)}; }
                        else r = *(const f32x4*)((const float*)rb + roff + col0 + co);
                        *(f32x4*)(rowp + co) = acc[ai][bj][m][n] + alpha * r; } }
    }
};
struct EpiResToBf16 {
    static constexpr bool PERM = true;
    bf16_t* H; const float* x0; const float* x1; int split_row; float alpha;
    __device__ __forceinline__ void operator()(const f32x4 (&acc)[2][2][4][2], const Unit& u, int wr, int wc, int fr, int fq) const {
        const int row0 = u.pm * BM + wr * 64 + fr, col0 = u.pn * BM + wc * 32 + 8 * fq;
#pragma unroll
        for (int ai = 0; ai < 2; ++ai)
#pragma unroll
            for (int m = 0; m < 4; ++m) { const int row = row0 + ai * HALF + m * 16;
                const float* xr = ((row < split_row) ? x0 + (size_t)row * 1024 : x1 + (size_t)(row - split_row) * 1024) + col0;
#pragma unroll
                for (int bj = 0; bj < 2; ++bj) { const f32x4 xa = *(const f32x4*)(xr + bj * HALF), xb = *(const f32x4*)(xr + bj * HALF + 4);
                    const f32x4 v0 = acc[ai][bj][m][0] + alpha * xa, v1 = acc[ai][bj][m][1] + alpha * xb;
                    u32x4 w; w.x = cvt_pk_bf16(v0[0], v0[1]); w.y = cvt_pk_bf16(v0[2], v0[3]); w.z = cvt_pk_bf16(v1[0], v1[1]); w.w = cvt_pk_bf16(v1[2], v1[3]);
                    *(u32x4*)(H + (size_t)row * 1024 + col0 + bj * HALF) = w; } }
    }
};
}

template <int MODE>
__device__ __forceinline__ void wprep_mat(const Params& p, float* tile, const float* src, const int N, const int ntn, const int njobs, const int bid0, const int nb) {
    const int tid = opaque_tid();
    for (int job = bid0; job < njobs; job += nb) {
        const int kt = job / ntn, nt = job % ntn, k0 = kt * 64, n0 = nt * 64;
        { const int kr = tid >> 4, nc = (tid & 15) * 4;
#pragma unroll
          for (int ps = 0; ps < 2; ++ps) { const int k = k0 + kr + ps * 32, n = n0 + nc; f32x4 v = (f32x4){0.f, 0.f, 0.f, 0.f};
              if (n < N) v = *(const f32x4*)(src + (size_t)k * N + n);
              float* tp = tile + (kr + ps * 32) * 65 + nc; tp[0] = v[0]; tp[1] = v[1]; tp[2] = v[2]; tp[3] = v[3]; } }
        __syncthreads();
        { const int nr = tid >> 3, kc = (tid & 7) * 8, n = n0 + nr;
          if (n < N) { float v[8];
#pragma unroll
              for (int e = 0; e < 8; ++e) v[e] = tile[(kc + e) * 65 + nr];
              u32x4 w; w.x = cvt_pk_bf16(v[0], v[1]); w.y = cvt_pk_bf16(v[2], v[3]); w.z = cvt_pk_bf16(v[4], v[5]); w.w = cvt_pk_bf16(v[6], v[7]);
              size_t doff;
              if (MODE == 0) {
                  if (n < 512) doff = OFF_WMAIN + (size_t)(1536 + n) * 2048;
                  else if (n < 1024) doff = OFF_WMAIN + (size_t)(2048 + n - 512) * 2048;
                  else if (n < 1536) doff = OFF_WV + (size_t)(n - 1024) * 2048;
                  else if (n < 2048) doff = OFF_WMAIN + (size_t)(n - 1536) * 2048;
                  else if (n < 2560) doff = OFF_WMAIN + (size_t)(512 + n - 2048) * 2048;
                  else if (n < 3072) doff = OFF_WMAIN + (size_t)(1024 + n - 2560) * 2048;
                  else if (n < 3584) doff = OFF_WMAIN + (size_t)(2560 + n - 3072) * 2048;
                  else doff = OFF_WG + (size_t)(n - 3584) * 2048;
              } else if (MODE == 1) doff = OFF_WOUT + (size_t)n * 2048;
              else if (MODE == 2) doff = OFF_WUP + (size_t)n * 2048;
              else doff = OFF_WDOWN + (size_t)n * 5632;
              *(u32x4*)(p.ws + doff + (size_t)(k0 + kc) * 2) = w; } }
        __syncthreads();
    }
}
__device__ __forceinline__ void phase_wprep(const Params& p, unsigned char* smem, const int part, const int bid0, const int nb) {
    float* tile = (float*)smem;
    if (part == 0) wprep_mat<0>(p, tile, p.w_in, 3600, 57, 912, bid0, nb);
    else if (part == 1) { wprep_mat<1>(p, tile, p.w_out, 1024, 16, 256, bid0, nb); wprep_mat<3>(p, tile, p.w_down, 1024, 16, 704, bid0, nb); }
    else wprep_mat<2>(p, tile, p.w_up, 5632, 88, 1408, bid0, nb);
}

__device__ __forceinline__ void phase_xconv(const Params& p, unsigned char* smem) {
    bf16_t* wg = (bf16_t*)smem; bf16_t* tile = (bf16_t*)(smem + 33024); float* red = (float*)(smem + 66048);
    const int tid = opaque_tid(), wid = tid >> 6, lane = tid & 63, c = lane & 15, g = lane >> 4;
    for (int idx = tid; idx < 16384; idx += 512) { const int k = idx >> 4, n = idx & 15; wg[n * 1032 + k] = f2bf(p.w_in[(size_t)k * 3600 + 3584 + n]); }
    bf16_t* xb = (bf16_t*)(p.ws + OFF_XB);
    float* gates = (float*)((unsigned char*)p.out + OOFF_GATES);
    const int row = tid >> 5, seg = tid & 31;
    f32x4 cur[8];
    int grp = blockIdx.x;
    if (grp < T_TOK / 16) { const float* src = xrow(p, grp * 16 + row) + 4 * seg;
#pragma unroll
        for (int j = 0; j < 8; ++j) cur[j] = *(const f32x4*)(src + 128 * j); }
    __syncthreads();
    for (; grp < T_TOK / 16; grp += gridDim.x) {
        bf16_t* dst = xb + (size_t)(grp * 16 + row) * 1024 + 4 * seg;
#pragma unroll
        for (int j = 0; j < 8; ++j) { u32x2 w; w.x = cvt_pk_bf16(cur[j][0], cur[j][1]); w.y = cvt_pk_bf16(cur[j][2], cur[j][3]);
            *(u32x2*)(dst + 128 * j) = w; *(u32x2*)(tile + row * 1032 + 128 * j + 4 * seg) = w; }
        const int nxt = grp + gridDim.x;
        if (nxt < T_TOK / 16) { const float* src = xrow(p, nxt * 16 + row) + 4 * seg;
#pragma unroll
            for (int j = 0; j < 8; ++j) cur[j] = *(const f32x4*)(src + 128 * j); }
        __syncthreads();
        { f32x4 acc = (f32x4){0.f, 0.f, 0.f, 0.f};
#pragma unroll
          for (int ks = 0; ks < 4; ++ks) { const bf16x8 af = *(const bf16x8*)(tile + c * 1032 + 128 * wid + 32 * ks + 8 * g), bfr = *(const bf16x8*)(wg + c * 1032 + 128 * wid + 32 * ks + 8 * g);
              acc = __builtin_amdgcn_mfma_f32_16x16x32_bf16(af, bfr, acc, 0, 0, 0); }
#pragma unroll
          for (int i = 0; i < 4; ++i) red[wid * 256 + (4 * g + i) * 16 + c] = acc[i]; }
        __syncthreads();
        if (tid < 256) { float sum = 0.f;
#pragma unroll
            for (int w = 0; w < 8; ++w) sum += red[w * 256 + tid];
            gates[(size_t)grp * 256 + tid] = sum; }
        __syncthreads();
    }
}

__device__ __forceinline__ void phase_na(const Params& p, unsigned char* smem) {
    float* rpbs = (float*)smem;
    const int tid = opaque_tid(), wid = tid >> 6, lane = tid & 63, c = lane & 15, g = lane >> 4;
    for (int i = tid; i < 8 * 15 * 31; i += 512) rpbs[i] = p.rpb[i];
    __syncthreads();
    const bf16_t* QK = (const bf16_t*)(p.ws + OFF_NA2);
    const bf16_t* VT = (const bf16_t*)(p.ws + OFF_VT);
    bf16_t* mix = (bf16_t*)(p.ws + OFF_MIX);
    const bool xcd_order = (gridDim.x == 256);
    const int nsteps = xcd_order ? 12 : (3072 + (int)gridDim.x - 1) / (int)gridDim.x;
    for (int step = 0; step < nsteps; ++step) {
        int plane, rp2;
        if (xcd_order) { const int xcd = blockIdx.x & 7, idx = blockIdx.x >> 3; plane = xcd * 48 + step * 4 + (idx >> 3); rp2 = idx & 7; }
        else { const int sid = step * (int)gridDim.x + (int)blockIdx.x; if (sid >= 3072) break; plane = sid >> 3; rp2 = sid & 7; }
        const int b = plane >> 3, h = plane & 7;
        const int r0 = 2 * (2 * rp2 + (wid >> 2)), cb = wid & 3;
        const int rsA = min(max(r0 - 4, 0), 24), rsB = min(max(r0 - 3, 0), 24), dB = rsB - rsA;
        const int kc0 = min(max(cb * 16 - 8, 0), 32);
        const int qc = cb * 16 + c, tokqA = b * SEQL + r0 * 64 + qc, tokqB = tokqA + 64;
        bf16x8 qA[2], qB[2];
#pragma unroll
        for (int ks = 0; ks < 2; ++ks) {
            qA[ks] = *(const bf16x8*)(QK + (size_t)h * ((size_t)T_TOK * 64) + (size_t)(tokqA >> 3) * 512 + ks * 256 + (tokqA & 7) * 32 + 8 * g);
            qB[ks] = *(const bf16x8*)(QK + (size_t)h * ((size_t)T_TOK * 64) + (size_t)(tokqB >> 3) * 512 + ks * 256 + (tokqB & 7) * 32 + 8 * g); }
        const int th = c + (cb == 0 ? -8 : (cb == 3 ? 8 : 0));
        bool use0[4]; int dcs[4];
#pragma unroll
        for (int i = 0; i < 4; ++i) { use0[i] = (4 * g + i) >= th; const int kc = kc0 + 4 * g + i + (use0[i] ? 0 : 16); dcs[i] = kc - qc + 15; }
        float sA[8][4], tB[9][4];
        {
            const bf16_t* kplane = QK + (size_t)(8 + h) * ((size_t)T_TOK * 64) + (c & 7) * 32 + 8 * g;
            const size_t tok0 = (size_t)b * SEQL + kc0 + c;
#pragma unroll
            for (int jj = 0; jj < 9; ++jj) {
                const int row = min(rsA + jj, 31);
                const bf16_t* kb = kplane + ((tok0 + row * 64) >> 3) * 512;
                bf16x8 kf[2][2];
#pragma unroll
                for (int kt = 0; kt < 2; ++kt)
#pragma unroll
                    for (int ks = 0; ks < 2; ++ks) kf[kt][ks] = *(const bf16x8*)(kb + kt * 2 * 512 + ks * 256);
                f32x4 aA[2], aB[2];
#pragma unroll
                for (int kt = 0; kt < 2; ++kt) {
                    aA[kt] = (f32x4){0.f, 0.f, 0.f, 0.f}; aB[kt] = (f32x4){0.f, 0.f, 0.f, 0.f};
#pragma unroll
                    for (int ks = 0; ks < 2; ++ks) { if (jj < 8) aA[kt] = __builtin_amdgcn_mfma_f32_16x16x32_bf16(kf[kt][ks], qA[ks], aA[kt], 0, 0, 0);
                        aB[kt] = __builtin_amdgcn_mfma_f32_16x16x32_bf16(kf[kt][ks], qB[ks], aB[kt], 0, 0, 0); } }
#pragma unroll
                for (int i = 0; i < 4; ++i) { if (jj < 8) sA[jj][i] = use0[i] ? aA[0][i] : aA[1][i]; tB[jj][i] = use0[i] ? aB[0][i] : aB[1][i]; }
            }
        }
        float sB[8][4];
#pragma unroll
        for (int j = 0; j < 8; ++j) {
            const float* browA = rpbs + (h * 15 + (rsA + j - r0 + 7)) * 31;
            const float* browB = rpbs + (h * 15 + (rsB + j - r0 + 6)) * 31;
#pragma unroll
            for (int i = 0; i < 4; ++i) { sA[j][i] = sA[j][i] * 0.125f + browA[dcs[i]]; sB[j][i] = (dB ? tB[j + 1][i] : tB[j][i]) * 0.125f + browB[dcs[i]]; }
        }
        float mxA = -1e30f, mxB = -1e30f;
#pragma unroll
        for (int j = 0; j < 8; ++j)
#pragma unroll
            for (int i = 0; i < 4; ++i) { mxA = fmaxf(mxA, sA[j][i]); mxB = fmaxf(mxB, sB[j][i]); }
        mxA = fmaxf(mxA, __shfl_xor(mxA, 16)); mxA = fmaxf(mxA, __shfl_xor(mxA, 32));
        mxB = fmaxf(mxB, __shfl_xor(mxB, 16)); mxB = fmaxf(mxB, __shfl_xor(mxB, 32));
        float sumA = 0.f, sumB = 0.f;
        unsigned pA[8][2], pB[8][2];
#pragma unroll
        for (int j = 0; j < 8; ++j) { float eA[4], eB[4];
#pragma unroll
            for (int i = 0; i < 4; ++i) { eA[i] = __expf(sA[j][i] - mxA); sumA += eA[i]; eB[i] = __expf(sB[j][i] - mxB); sumB += eB[i]; }
            pA[j][0] = cvt_pk_bf16(eA[0], eA[1]); pA[j][1] = cvt_pk_bf16(eA[2], eA[3]); pB[j][0] = cvt_pk_bf16(eB[0], eB[1]); pB[j][1] = cvt_pk_bf16(eB[2], eB[3]); }
        sumA += __shfl_xor(sumA, 16); sumA += __shfl_xor(sumA, 32);
        sumB += __shfl_xor(sumB, 16); sumB += __shfl_xor(sumB, 32);
        f32x4 oA[4], oB[4];
#pragma unroll
        for (int mt = 0; mt < 4; ++mt) { oA[mt] = (f32x4){0.f, 0.f, 0.f, 0.f}; oB[mt] = (f32x4){0.f, 0.f, 0.f, 0.f}; }
        {
            const bf16_t* vplane = VT + (size_t)h * ((size_t)T_TOK * 64) + c * 4;
            const size_t tk0 = (size_t)b * SEQL + kc0 + 4 * g;
#pragma unroll
            for (int jj = 0; jj < 9; ++jj) {
                const int row = min(rsA + jj, 31);
                const bf16_t* vb = vplane + ((tk0 + row * 64) >> 2) * 256;
                u32x2 vlo[4], vhi[4];
#pragma unroll
                for (int mt = 0; mt < 4; ++mt) { vlo[mt] = *(const u32x2*)(vb + mt * 64); vhi[mt] = *(const u32x2*)(vb + mt * 64 + 1024); }
                unsigned b01, b23;
                if (jj == 0) { b01 = dB ? 0u : pB[0][0]; b23 = dB ? 0u : pB[0][1]; }
                else if (jj == 8) { b01 = dB ? pB[7][0] : 0u; b23 = dB ? pB[7][1] : 0u; }
                else { b01 = dB ? pB[jj - 1][0] : pB[jj][0]; b23 = dB ? pB[jj - 1][1] : pB[jj][1]; }
                u32x4 pwB;
                pwB.x = (use0[0] ? (b01 & 0xffffu) : 0u) | (use0[1] ? (b01 & 0xffff0000u) : 0u);
                pwB.y = (use0[2] ? (b23 & 0xffffu) : 0u) | (use0[3] ? (b23 & 0xffff0000u) : 0u);
                pwB.z = (use0[0] ? 0u : (b01 & 0xffffu)) | (use0[1] ? 0u : (b01 & 0xffff0000u));
                pwB.w = (use0[2] ? 0u : (b23 & 0xffffu)) | (use0[3] ? 0u : (b23 & 0xffff0000u));
                u32x4 pwA = (u32x4){0u, 0u, 0u, 0u};
                if (jj < 8) { const unsigned a01 = pA[jj][0], a23 = pA[jj][1];
                    pwA.x = (use0[0] ? (a01 & 0xffffu) : 0u) | (use0[1] ? (a01 & 0xffff0000u) : 0u);
                    pwA.y = (use0[2] ? (a23 & 0xffffu) : 0u) | (use0[3] ? (a23 & 0xffff0000u) : 0u);
                    pwA.z = (use0[0] ? 0u : (a01 & 0xffffu)) | (use0[1] ? 0u : (a01 & 0xffff0000u));
                    pwA.w = (use0[2] ? 0u : (a23 & 0xffffu)) | (use0[3] ? 0u : (a23 & 0xffff0000u)); }
#pragma unroll
                for (int mt = 0; mt < 4; ++mt) {
                    u32x4 vw; vw.x = vlo[mt].x; vw.y = vlo[mt].y; vw.z = vhi[mt].x; vw.w = vhi[mt].y;
                    if (jj < 8) oA[mt] = __builtin_amdgcn_mfma_f32_16x16x32_bf16(as_bf16x8(vw), as_bf16x8(pwA), oA[mt], 0, 0, 0);
                    oB[mt] = __builtin_amdgcn_mfma_f32_16x16x32_bf16(as_bf16x8(vw), as_bf16x8(pwB), oB[mt], 0, 0, 0); }
            }
        }
        const float invA = __builtin_amdgcn_rcpf(sumA), invB = __builtin_amdgcn_rcpf(sumB);
#pragma unroll
        for (int mt = 0; mt < 4; ++mt) {
            u32x2 w; w.x = cvt_pk_bf16(oA[mt][0] * invA, oA[mt][1] * invA); w.y = cvt_pk_bf16(oA[mt][2] * invA, oA[mt][3] * invA);
            *(u32x2*)(mix + (size_t)tokqA * 1024 + h * 64 + mt * 16 + 4 * g) = w;
            u32x2 w2; w2.x = cvt_pk_bf16(oB[mt][0] * invB, oB[mt][1] * invB); w2.y = cvt_pk_bf16(oB[mt][2] * invB, oB[mt][3] * invB);
            *(u32x2*)(mix + (size_t)tokqB * 1024 + h * 64 + mt * 16 + 4 * g) = w2; }
    }
}

typedef short bf16x4 __attribute__((ext_vector_type(4)));
__device__ __forceinline__ bf16x4 as_bf16x4(u32x2 v) { union { u32x2 u; bf16x4 b; } c; c.u = v; return c.b; }
__device__ __forceinline__ float sel4(float a0, float a1, float a2, float a3, int k) { return k == 0 ? a0 : (k == 1 ? a1 : (k == 2 ? a2 : a3)); }
constexpr int PL_KS = 0, PL_VS = 17408, PL_QS = 34816, PL_M1 = 52224, PL_M2 = 68864, PL_XT = 34816, PL_LB = 85504, PL_DT = 103936, PL_GC = 112128, PL_BETA = 112640, PL_EGC = 113152, PL_EGL = 113664, PL_BEG = 114176, PL_WS = 114688, PL_TB = 122880;

template <int D>
__device__ __forceinline__ void prep_attn(const int tid, unsigned char* smem, unsigned char* prep, const int bl, const int h, const int n) {
    const float* M1 = (const float*)(smem + PL_M1); const float* M2 = (const float*)(smem + PL_M2);
    bf16_t* Lb = (bf16_t*)(smem + PL_LB) + D * 64 * 72; float* DT = (float*)(smem + PL_DT) + D * 1024;
    const float* gcs = (const float*)(smem + PL_GC) + D * 64; const float* betas = (const float*)(smem + PL_BETA) + D * 64;
    const size_t pidx = ((size_t)(bl * 4 + h) * 2 + D) * 32 + (D ? 31 - n : n);
    unsigned char* pout = prep + pidx * PREP_ITEM;
    const int t = tid & 255, ip = t >> 2, jb = (t & 3) * 16;
    const float gi = gcs[ip], bi = betas[ip]; const int oi = D ? 63 - ip : ip;
    const float* m1r = M1 + oi * 65 + (D ? 63 - jb : jb); const float* m2r = M2 + oi * 65 + (D ? 63 - jb : jb);
    float av[16], lv[16];
#pragma unroll
    for (int jj = 0; jj < 16; ++jj) { const int jp = jb + jj;
        const float dec = (ip >= jp) ? __expf(gi - gcs[jp]) : 0.f;
        lv[jj] = (ip > jp) ? bi * m1r[D ? -jj : jj] * dec : 0.f;
        av[jj] = m2r[D ? -jj : jj] * dec; }
    { u32x4 w0, w1; w0.x = cvt_pk_bf16(lv[0], lv[1]); w0.y = cvt_pk_bf16(lv[2], lv[3]); w0.z = cvt_pk_bf16(lv[4], lv[5]); w0.w = cvt_pk_bf16(lv[6], lv[7]);
      w1.x = cvt_pk_bf16(lv[8], lv[9]); w1.y = cvt_pk_bf16(lv[10], lv[11]); w1.z = cvt_pk_bf16(lv[12], lv[13]); w1.w = cvt_pk_bf16(lv[14], lv[15]);
      *(u32x4*)(Lb + ip * 72 + jb) = w0; *(u32x4*)(Lb + ip * 72 + jb + 8) = w1; }
    if ((ip >> 4) == (jb >> 4)) { float* dt = DT + (ip >> 4) * 256 + (ip & 15);
#pragma unroll
        for (int jj = 0; jj < 16; ++jj) dt[jj * 16] = lv[jj]; }
    bf16_t* arow = (bf16_t*)(pout + PI_ATTN) + ip * 64 + (jb & 32) + ((jb >> 4) & 1) * 4;
#pragma unroll
    for (int gg = 0; gg < 4; ++gg) { u32x2 w; w.x = cvt_pk_bf16(av[4 * gg], av[4 * gg + 1]); w.y = cvt_pk_bf16(av[4 * gg + 2], av[4 * gg + 3]); *(u32x2*)(arow + 8 * gg) = w; }
}
template <int D>
__device__ __forceinline__ void prep_qdk(const int tid, unsigned char* smem, unsigned char* prep, float* cdarr, const int bl, const int h, const int n) {
    const bf16_t* qs = (const bf16_t*)(smem + PL_QS); const bf16_t* ks = (const bf16_t*)(smem + PL_KS);
    const float* gcs = (const float*)(smem + PL_GC) + D * 64;
    const size_t pidx = ((size_t)(bl * 4 + h) * 2 + D) * 32 + (D ? 31 - n : n);
    unsigned char* pout = prep + pidx * PREP_ITEM;
    const float* egc = (const float*)(smem + PL_EGC) + D * 64; const float* egl = (const float*)(smem + PL_EGL) + D * 64;
    const int t = tid & 255;
#pragma unroll
    for (int rep = 0; rep < 4; ++rep) { const int id = t + rep * 256, ip = id >> 4, q = id & 15, kt = q >> 2, gg = q & 3, oi = D ? 63 - ip : ip;
        const float e = egc[ip];
        const u32x2 lo = *(const u32x2*)(qs + oi * 136 + kt * 32 + 4 * gg), hi = *(const u32x2*)(qs + oi * 136 + kt * 32 + 16 + 4 * gg);
        u32x4 w; w.x = cvt_pk_bf16(bflo(lo.x) * e, bfhi(lo.x) * e); w.y = cvt_pk_bf16(bflo(lo.y) * e, bfhi(lo.y) * e);
        w.z = cvt_pk_bf16(bflo(hi.x) * e, bfhi(hi.x) * e); w.w = cvt_pk_bf16(bflo(hi.y) * e, bfhi(hi.y) * e);
        *(u32x4*)((bf16_t*)(pout + PI_QD) + ip * 128 + q * 8) = w; }
#pragma unroll
    for (int rep = 0; rep < 4; ++rep) { const int id = t + rep * 256, dk = id >> 3, q = id & 7, kt = q >> 2, gg = q & 3;
        float v[8];
#pragma unroll
        for (int sidx = 0; sidx < 8; ++sidx) { const int ip = kt * 32 + (sidx >> 2) * 16 + 4 * gg + (sidx & 3), oi = D ? 63 - ip : ip;
            v[sidx] = bf2f(ks[oi * 136 + dk]) * egl[ip]; }
        u32x4 w; w.x = cvt_pk_bf16(v[0], v[1]); w.y = cvt_pk_bf16(v[2], v[3]); w.z = cvt_pk_bf16(v[4], v[5]); w.w = cvt_pk_bf16(v[6], v[7]);
        *(u32x4*)((bf16_t*)(pout + PI_KDT) + dk * 64 + q * 8) = w; }
    if (t == 0) cdarr[pidx] = egc[63];
}
__device__ __forceinline__ void prep_inv(const int t, unsigned char* smem) {
    const int d = t >> 6, blk = (t >> 4) & 3, jj = t & 15;
    const float* DTb = (const float*)(smem + PL_DT) + d * 1024 + blk * 256;
    bf16_t* Tb = (bf16_t*)(smem + PL_TB) + (d * 4 + blk) * 256;
    float y[16];
#pragma unroll
    for (int i = 0; i < 16; ++i) y[i] = (i == jj) ? 1.f : 0.f;
#pragma unroll
    for (int k = 0; k < 15; ++k) { const float yk = y[k];
#pragma unroll
        for (int i4 = (k + 1) / 4; i4 < 4; ++i4) { const f32x4 a = *(const f32x4*)(DTb + k * 16 + i4 * 4);
#pragma unroll
            for (int q = 0; q < 4; ++q) if (i4 * 4 + q > k) y[i4 * 4 + q] -= a[q] * yk; } }
#pragma unroll
    for (int i = 0; i < 16; ++i) Tb[i * 16 + jj] = f2bf(y[i]);
}
template <int D>
__device__ __forceinline__ void prep_solve(const int tid, unsigned char* smem, unsigned char* prep, const int bl, const int h, const int n) {
    const bf16_t* ks = (const bf16_t*)(smem + PL_KS); const bf16_t* vs = (const bf16_t*)(smem + PL_VS);
    const bf16_t* Lb = (const bf16_t*)(smem + PL_LB) + D * 64 * 72; const bf16_t* Tb = (const bf16_t*)(smem + PL_TB) + D * 1024;
    bf16_t* XT = (bf16_t*)(smem + PL_XT) + D * 256 * 48;
    const size_t pidx = ((size_t)(bl * 4 + h) * 2 + D) * 32 + (D ? 31 - n : n);
    unsigned char* pout = prep + pidx * PREP_ITEM;
    const int w4 = (tid >> 6) & 3, lane = tid & 63, c = lane & 15, g = lane >> 4;
    const bool isw = w4 >= 2; const bf16_t* src = (isw ? ks : vs) + ((64 * w4 + c) & 127);
    const float* scl = (const float*)(smem + (isw ? PL_BEG : PL_BETA)) + D * 64;
    bf16_t* wst = (bf16_t*)(smem + PL_WS) + (D * 2 + (w4 & 1)) * 1024;
#pragma unroll 1
    for (int r = 0; r < 4; ++r) {
        f32x4 acc[4];
#pragma unroll
        for (int nt = 0; nt < 4; ++nt) acc[nt] = (f32x4){0.f, 0.f, 0.f, 0.f};
        for (int kk = 0; kk < r; ++kk) {
            const bf16x4 af = as_bf16x4(*(const u32x2*)(Lb + (16 * r + c) * 72 + 16 * kk + 4 * g));
#pragma unroll
            for (int nt = 0; nt < 4; ++nt) { const bf16x4 bfr = as_bf16x4(*(const u32x2*)(XT + (64 * w4 + 16 * nt + c) * 48 + 16 * kk + 4 * g));
                acc[nt] = __builtin_amdgcn_mfma_f32_16x16x16bf16_1k(af, bfr, acc[nt], 0, 0, 0); }
        }
        const f32x4 sc4 = *(const f32x4*)(scl + 16 * r + 4 * g);
        const bf16x4 tf = as_bf16x4(*(const u32x2*)(Tb + r * 256 + c * 16 + 4 * g));
        f32x4 X[4];
#pragma unroll
        for (int nt = 0; nt < 4; ++nt) { float rr[4];
#pragma unroll
            for (int i = 0; i < 4; ++i) { const int tok = 16 * r + 4 * g + i, oi = D ? 63 - tok : tok; rr[i] = bf2f(src[oi * 136 + 16 * nt]) * sc4[i] - acc[nt][i]; }
            u32x2 rb; rb.x = cvt_pk_bf16(rr[0], rr[1]); rb.y = cvt_pk_bf16(rr[2], rr[3]);
            X[nt] = __builtin_amdgcn_mfma_f32_16x16x16bf16_1k(tf, as_bf16x4(rb), (f32x4){0.f, 0.f, 0.f, 0.f}, 0, 0, 0); }
        u32x2 xb[4];
#pragma unroll
        for (int nt = 0; nt < 4; ++nt) { xb[nt].x = cvt_pk_bf16(X[nt][0], X[nt][1]); xb[nt].y = cvt_pk_bf16(X[nt][2], X[nt][3]); }
        if (r < 3) {
#pragma unroll
            for (int nt = 0; nt < 4; ++nt) *(u32x2*)(XT + (64 * w4 + 16 * nt + c) * 48 + 16 * r + 4 * g) = xb[nt]; }
        if (!isw) {
#pragma unroll
            for (int nt = 0; nt < 4; ++nt) *(u32x2*)((bf16_t*)(pout + PI_UT) + (64 * w4 + 16 * nt + c) * 64 + 16 * r + 4 * g) = xb[nt]; }
        else {
#pragma unroll
            for (int nt = 0; nt < 4; ++nt) { const int pc = perm_k(64 * (w4 & 1) + 16 * nt + c) & 63;
                wst[(4 * g + 0) * 64 + pc] = (bf16_t)(xb[nt].x & 0xffffu); wst[(4 * g + 1) * 64 + pc] = (bf16_t)(xb[nt].x >> 16);
                wst[(4 * g + 2) * 64 + pc] = (bf16_t)(xb[nt].y & 0xffffu); wst[(4 * g + 3) * 64 + pc] = (bf16_t)(xb[nt].y >> 16); }
#pragma unroll
            for (int rep = 0; rep < 2; ++rep) { const int q = lane + 64 * rep, row = q >> 3, ch = q & 7;
                const u32x4 v = *(const u32x4*)(wst + row * 64 + ch * 8);
                *(u32x4*)((bf16_t*)(pout + PI_W) + (16 * r + row) * 128 + 64 * (w4 & 1) + ch * 8) = v; }
        }
    }
}

__device__ __forceinline__ void phase_prep(const Params& p, int grp, unsigned char* smem_base) {
    const bf16_t* seg = (const bf16_t*)(p.ws + OFF_SEG);
    const float* gates = (const float*)((const unsigned char*)p.out + OOFF_GATES);
    unsigned char* prep = p.ws + OFF_PREP; float* cdarr = (float*)(p.ws + OFF_CD);
    u32x4 rows_nx[12];
    { const int tid0 = opaque_tid(), it0 = blockIdx.x;
#pragma unroll
      for (int rr = 0; rr < 12; ++rr) rows_nx[rr] = (u32x4){0u, 0u, 0u, 0u};
      if (tid0 < 384 && it0 < 3072) { const int which = tid0 >> 7, tb = (tid0 & 127) >> 4, cgp = tid0 & 15, hn = it0 & 3, nn = (it0 >> 2) & 31, bn = grp * 24 + (it0 >> 7);
#pragma unroll
        for (int rr = 0; rr < 12; ++rr) { const int pos = nn * 64 + tb * 8 - 2 + rr;
            if (pos >= 0 && pos < SEQL) rows_nx[rr] = *(const u32x4*)(seg + which * 512 + ((size_t)bn * SEQL + pos) * 1536 + hn * 128 + cgp * 8); } } }
    for (int it = blockIdx.x; it < 3072; it += gridDim.x) {
        const int h = it & 3, n = (it >> 2) & 31, bl = it >> 7, b = grp * 24 + bl;
        const int tid = opaque_tid();
        const int wid = tid >> 6, lane = tid & 63, c = lane & 15, g = lane >> 4;
        int lofs = 0; asm volatile("" : "+s"(lofs));
        unsigned char* smem = smem_base + lofs;
        bf16_t* qs = (bf16_t*)(smem + PL_QS); bf16_t* ks = (bf16_t*)(smem + PL_KS); bf16_t* vs = (bf16_t*)(smem + PL_VS);
        float* M1 = (float*)(smem + PL_M1); float* M2 = (float*)(smem + PL_M2);
        float* gcs = (float*)(smem + PL_GC); float* betas = (float*)(smem + PL_BETA);
        const size_t tok0 = (size_t)b * SEQL + n * 64;
        if (tid < 384) {
            const int which = tid >> 7, tb = (tid & 127) >> 4, cgp = tid & 15, chan = h * 128 + cgp * 8;
            const bf16_t* sg = seg + which * 512;
            float cw[5][8];
#pragma unroll
            for (int j = 0; j < 5; ++j) { const f32x4 w0 = *(const f32x4*)(p.gconv + j * 1536 + which * 512 + chan), w1 = *(const f32x4*)(p.gconv + j * 1536 + which * 512 + chan + 4);
                cw[j][0] = w0[0]; cw[j][1] = w0[1]; cw[j][2] = w0[2]; cw[j][3] = w0[3]; cw[j][4] = w1[0]; cw[j][5] = w1[1]; cw[j][6] = w1[2]; cw[j][7] = w1[3]; }
            u32x4 rows[12];
#pragma unroll
            for (int rr = 0; rr < 12; ++rr) rows[rr] = rows_nx[rr];
            bf16_t* dst = (which == 0 ? qs : (which == 1 ? ks : vs)) + cgp * 8;
#pragma unroll
            for (int tt = 0; tt < 8; ++tt) {
                float y[8];
#pragma unroll
                for (int e = 0; e < 8; ++e) y[e] = 0.f;
#pragma unroll
                for (int j = 0; j < 5; ++j) { const u32x4 rv = rows[tt + j];
                    y[0] += cw[j][0] * bflo(rv.x); y[1] += cw[j][1] * bfhi(rv.x); y[2] += cw[j][2] * bflo(rv.y); y[3] += cw[j][3] * bfhi(rv.y);
                    y[4] += cw[j][4] * bflo(rv.z); y[5] += cw[j][5] * bfhi(rv.z); y[6] += cw[j][6] * bflo(rv.w); y[7] += cw[j][7] * bfhi(rv.w); }
                float ss = 0.f;
#pragma unroll
                for (int e = 0; e < 8; ++e) { y[e] = silu_f(y[e]); ss += y[e] * y[e]; }
                ss += __shfl_xor(ss, 1); ss += __shfl_xor(ss, 2); ss += __shfl_xor(ss, 4); ss += __shfl_xor(ss, 8);
                const float sc = (which == 0) ? rsqrtf(ss + 1e-6f) * 0.08838834764831845f : ((which == 1) ? rsqrtf(ss + 1e-6f) : 1.f);
                u32x4 w; w.x = cvt_pk_bf16(y[0] * sc, y[1] * sc); w.y = cvt_pk_bf16(y[2] * sc, y[3] * sc); w.z = cvt_pk_bf16(y[4] * sc, y[5] * sc); w.w = cvt_pk_bf16(y[6] * sc, y[7] * sc);
                *(u32x4*)(dst + (tb * 8 + tt) * 136) = w;
            }
            { const int itn = it + gridDim.x;
              if (itn < 3072) { const int hn = itn & 3, nn = (itn >> 2) & 31, bn = grp * 24 + (itn >> 7);
#pragma unroll
                for (int rr = 0; rr < 12; ++rr) { const int pos = nn * 64 + tb * 8 - 2 + rr; rows_nx[rr] = (u32x4){0u, 0u, 0u, 0u};
                    if (pos >= 0 && pos < SEQL) rows_nx[rr] = *(const u32x4*)(seg + which * 512 + ((size_t)bn * SEQL + pos) * 1536 + hn * 128 + cgp * 8); } } }
        } else if (wid >= 6) {
            const int d = wid - 6, li = d ? 63 - lane : lane;
            const float* gr = gates + (tok0 + li) * 16;
            const float bet = sigmoid_f(gr[d * 4 + h]);
            const float a = gr[8 + d * 4 + h] + p.dt_bias[d * 4 + h];
            const float sp = fmaxf(a, 0.f) + log1pf(__expf(-fabsf(a)));
            float gv = -__expf(p.a_log[d * 4 + h]) * sp;
#pragma unroll
            for (int off = 1; off < 64; off <<= 1) { const float t = __shfl_up(gv, off); if (lane >= off) gv += t; }
            gcs[d * 64 + lane] = gv; betas[d * 64 + lane] = bet;
            { const float eg = __expf(gv), gl = __shfl(gv, 63);
              ((float*)(smem + PL_EGC))[d * 64 + lane] = eg; ((float*)(smem + PL_EGL))[d * 64 + lane] = __expf(gl - gv); ((float*)(smem + PL_BEG))[d * 64 + lane] = bet * eg; }
        }
        __syncthreads();
        {
            const int which = wid >> 2, mt = wid & 3; const bf16_t* X = which ? qs : ks; float* M = which ? M2 : M1;
            bf16x8 af[4];
#pragma unroll
            for (int kk = 0; kk < 4; ++kk) af[kk] = *(const bf16x8*)(X + (mt * 16 + c) * 136 + kk * 32 + 8 * g);
#pragma unroll
            for (int nt = 0; nt < 4; ++nt) { f32x4 a = (f32x4){0.f, 0.f, 0.f, 0.f};
#pragma unroll
                for (int kk = 0; kk < 4; ++kk) { const bf16x8 bfr = *(const bf16x8*)(ks + (nt * 16 + c) * 136 + kk * 32 + 8 * g);
                    a = __builtin_amdgcn_mfma_f32_16x16x32_bf16(af[kk], bfr, a, 0, 0, 0); }
#pragma unroll
                for (int i = 0; i < 4; ++i) M[(mt * 16 + 4 * g + i) * 65 + nt * 16 + c] = a[i]; }
        }
        __syncthreads();
        if (tid < 256) prep_attn<0>(tid, smem, prep, bl, h, n); else prep_attn<1>(tid, smem, prep, bl, h, n);
        __syncthreads();
        if (tid < 128) prep_inv(tid, smem);
        if (tid < 256) prep_qdk<0>(tid, smem, prep, cdarr, bl, h, n); else prep_qdk<1>(tid, smem, prep, cdarr, bl, h, n);
        __syncthreads();
        if (tid < 256) prep_solve<0>(tid, smem, prep, bl, h, n); else prep_solve<1>(tid, smem, prep, bl, h, n);
        __syncthreads();
    }
}

constexpr int SL_W = 0, SL_QD = 17408, SL_ATTN = 34816, SL_KDT = 44032;
__device__ __forceinline__ void phase_scan(const Params& p, int grp, unsigned char* smem) {
    const int tid = opaque_tid(), wv = tid >> 6, lane = tid & 63, c = lane & 15, g = lane >> 4;
    const unsigned char* prep = p.ws + OFF_PREP; const float* cdarr = (const float*)(p.ws + OFF_CD);
    bf16_t* O4 = (bf16_t*)((unsigned char*)p.out + OOFF_O);
    (void)grp;
    constexpr int SBUF = 62464;
    for (int it = blockIdx.x; it < 192; it += gridDim.x) {
        const int d = it & 1, h = (it >> 1) & 3, bl = it >> 3;
        const unsigned char* pbase = prep + (size_t)it * 32 * PREP_ITEM; const float* cdp = cdarr + (size_t)it * 32;
        f32x4 S[8];
#pragma unroll
        for (int m = 0; m < 8; ++m) S[m] = (f32x4){0.f, 0.f, 0.f, 0.f};
        u32x4 st[7];
#define SCAN_LOAD(src) do { _Pragma("unroll") for (int k = 0; k < 7; ++k) st[k] = *(const u32x4*)((src) + (size_t)(tid + 512 * k) * 16); } while (0)
#define SCAN_STORE(sb) do { \
        _Pragma("unroll") for (int k = 0; k < 2; ++k) { const int id = tid + 512 * k; *(u32x4*)((sb) + SL_W + (id >> 4) * 272 + (id & 15) * 16) = st[k]; } \
        _Pragma("unroll") for (int k = 2; k < 4; ++k) { const int id = tid + 512 * (k - 2); *(u32x4*)((sb) + SL_QD + (id >> 4) * 272 + (id & 15) * 16) = st[k]; } \
        { const int id = tid; *(u32x4*)((sb) + SL_ATTN + (id >> 3) * 144 + (id & 7) * 16) = st[4]; } \
        _Pragma("unroll") for (int k = 5; k < 7; ++k) { const int id = tid + 512 * (k - 5); *(u32x4*)((sb) + SL_KDT + (id >> 3) * 144 + (id & 7) * 16) = st[k]; } } while (0)
        SCAN_LOAD(pbase); SCAN_STORE(smem);
        SCAN_LOAD(pbase + PREP_ITEM);
        u32x2 uun[4]; float cdn = cdp[0];
#pragma unroll
        for (int mt = 0; mt < 4; ++mt) uun[mt] = *(const u32x2*)(pbase + PI_UT + ((16 * wv + c) * 64 + 16 * mt + 4 * g) * 2);
        __syncthreads();
        for (int n = 0; n < 32; ++n) {
            const unsigned char* cur = pbase + (size_t)n * PREP_ITEM;
            unsigned char* sb = smem + (n & 1) * SBUF;
            if (n < 31) SCAN_STORE(smem + ((n + 1) & 1) * SBUF);
            if (n < 30) SCAN_LOAD(cur + 2 * PREP_ITEM);
            u32x2 uu[4]; const float cdv = cdn;
#pragma unroll
            for (int mt = 0; mt < 4; ++mt) uu[mt] = uun[mt];
            if (n < 31) { cdn = cdp[n + 1];
#pragma unroll
                for (int mt = 0; mt < 4; ++mt) uun[mt] = *(const u32x2*)(cur + PREP_ITEM + PI_UT + ((16 * wv + c) * 64 + 16 * mt + 4 * g) * 2); }
            bf16x8 Sb[4];
#pragma unroll
            for (int kt = 0; kt < 4; ++kt) { u32x4 w; w.x = cvt_pk_bf16(S[2 * kt][0], S[2 * kt][1]); w.y = cvt_pk_bf16(S[2 * kt][2], S[2 * kt][3]);
                w.z = cvt_pk_bf16(S[2 * kt + 1][0], S[2 * kt + 1][1]); w.w = cvt_pk_bf16(S[2 * kt + 1][2], S[2 * kt + 1][3]); Sb[kt] = as_bf16x8(w); }
            f32x4 av[4], ao[4];
#pragma unroll
            for (int mt = 0; mt < 4; ++mt) { f32x4 a = (f32x4){0.f, 0.f, 0.f, 0.f};
#pragma unroll
                for (int kt = 0; kt < 4; ++kt) { const bf16x8 af = *(const bf16x8*)(sb + SL_W + (16 * mt + c) * 272 + (32 * kt + 8 * g) * 2);
                    a = __builtin_amdgcn_mfma_f32_16x16x32_bf16(af, Sb[kt], a, 0, 0, 0); }
                av[mt] = a; }
#pragma unroll
            for (int mt = 0; mt < 4; ++mt) { f32x4 a = (f32x4){0.f, 0.f, 0.f, 0.f};
#pragma unroll
                for (int kt = 0; kt < 4; ++kt) { const bf16x8 af = *(const bf16x8*)(sb + SL_QD + (16 * mt + c) * 272 + (32 * kt + 8 * g) * 2);
                    a = __builtin_amdgcn_mfma_f32_16x16x32_bf16(af, Sb[kt], a, 0, 0, 0); }
                ao[mt] = a; }
            f32x4 v[4];
#pragma unroll
            for (int mt = 0; mt < 4; ++mt) v[mt] = (f32x4){bflo(uu[mt].x) - av[mt][0], bfhi(uu[mt].x) - av[mt][1], bflo(uu[mt].y) - av[mt][2], bfhi(uu[mt].y) - av[mt][3]};
            bf16x8 Vb[2];
#pragma unroll
            for (int kt = 0; kt < 2; ++kt) { u32x4 w; w.x = cvt_pk_bf16(v[2 * kt][0], v[2 * kt][1]); w.y = cvt_pk_bf16(v[2 * kt][2], v[2 * kt][3]);
                w.z = cvt_pk_bf16(v[2 * kt + 1][0], v[2 * kt + 1][1]); w.w = cvt_pk_bf16(v[2 * kt + 1][2], v[2 * kt + 1][3]); Vb[kt] = as_bf16x8(w); }
            const int no = d ? 31 - n : n;
#pragma unroll
            for (int mt = 0; mt < 4; ++mt) { f32x4 a = ao[mt];
#pragma unroll
                for (int kt = 0; kt < 2; ++kt) { const bf16x8 af = *(const bf16x8*)(sb + SL_ATTN + (16 * mt + c) * 144 + (32 * kt + 8 * g) * 2);
                    a = __builtin_amdgcn_mfma_f32_16x16x32_bf16(af, Vb[kt], a, 0, 0, 0); }
                ao[mt] = a; }
#pragma unroll
            for (int m8 = 0; m8 < 8; ++m8) { f32x4 a = S[m8] * cdv;
#pragma unroll
                for (int kt = 0; kt < 2; ++kt) { const bf16x8 af = *(const bf16x8*)(sb + SL_KDT + (16 * m8 + c) * 144 + (32 * kt + 8 * g) * 2);
                    a = __builtin_amdgcn_mfma_f32_16x16x32_bf16(af, Vb[kt], a, 0, 0, 0); }
                S[m8] = a; }
#pragma unroll
            for (int mt = 0; mt < 4; ++mt) {
                const int l0 = d ? 60 - 16 * mt - 4 * g : 16 * mt + 4 * g;
                u32x2 w; if (d) { w.x = cvt_pk_bf16(ao[mt][3], ao[mt][2]); w.y = cvt_pk_bf16(ao[mt][1], ao[mt][0]); }
                else { w.x = cvt_pk_bf16(ao[mt][0], ao[mt][1]); w.y = cvt_pk_bf16(ao[mt][2], ao[mt][3]); }
                *(u32x2*)(O4 + (((size_t)d * 12288 + (((size_t)bl * SEQL + no * 64 + l0) >> 2)) * 512 + h * 128 + 16 * wv + c) * 4) = w; }
            __syncthreads();
        }
#undef SCAN_LOAD
#undef SCAN_STORE
    }
}

__device__ __forceinline__ void phase_combine(const Params& p, int grp) {
    const bf16_t* O4 = (const bf16_t*)((const unsigned char*)p.out + OOFF_O);
    const bf16_t* Z = (const bf16_t*)((const unsigned char*)p.out + OOFF_Z);
    bf16_t* mix = (bf16_t*)(p.ws + OFF_MIX);
    const int total = 12288 * 4 * 32, nthr = gridDim.x * 512;
    const int q = opaque_tid() & 31;
    const f32x4 nwv = *(const f32x4*)(p.gnorm + 4 * q);
    for (int gt = blockIdx.x * 512 + opaque_tid(); gt < total; gt += nthr) {
        const int h = (gt >> 5) & 3, tg4 = gt >> 7;
        const bf16_t* of = O4 + ((size_t)tg4 * 512 + h * 128 + 4 * q) * 4; const bf16_t* ob = of + (size_t)12288 * 512 * 4;
        const u32x4 f0 = *(const u32x4*)of, f1 = *(const u32x4*)(of + 8), b0 = *(const u32x4*)ob, b1 = *(const u32x4*)(ob + 8);
        const size_t tokg = (size_t)grp * 49152 + (size_t)tg4 * 4;
        u32x2 zv[4];
#pragma unroll
        for (int t = 0; t < 4; ++t) zv[t] = *(const u32x2*)(Z + (tokg + t) * 512 + h * 128 + 4 * q);
        const unsigned fw[8] = {f0.x, f0.y, f0.z, f0.w, f1.x, f1.y, f1.z, f1.w}, bw[8] = {b0.x, b0.y, b0.z, b0.w, b1.x, b1.y, b1.z, b1.w};
        float o[4][4];
#pragma unroll
        for (int j = 0; j < 4; ++j) { o[j][0] = bflo(fw[2 * j]) + bflo(bw[2 * j]); o[j][1] = bfhi(fw[2 * j]) + bfhi(bw[2 * j]);
            o[j][2] = bflo(fw[2 * j + 1]) + bflo(bw[2 * j + 1]); o[j][3] = bfhi(fw[2 * j + 1]) + bfhi(bw[2 * j + 1]); }
#pragma unroll
        for (int t = 0; t < 4; ++t) {
            float ss = (o[0][t] * o[0][t] + o[1][t] * o[1][t]) + (o[2][t] * o[2][t] + o[3][t] * o[3][t]);
            ss += __shfl_xor(ss, 1); ss += __shfl_xor(ss, 2); ss += __shfl_xor(ss, 4); ss += __shfl_xor(ss, 8); ss += __shfl_xor(ss, 16);
            const float r = rsqrtf(ss * (1.f / 128.f) + 1e-6f);
            const float z0 = bflo(zv[t].x), z1 = bfhi(zv[t].x), z2 = bflo(zv[t].y), z3 = bfhi(zv[t].y);
            u32x2 w; w.x = cvt_pk_bf16(o[0][t] * r * nwv[0] * silu_f(z0), o[1][t] * r * nwv[1] * silu_f(z1)); w.y = cvt_pk_bf16(o[2][t] * r * nwv[2] * silu_f(z2), o[3][t] * r * nwv[3] * silu_f(z3));
            *(u32x2*)(mix + (tokg + t) * 1024 + 512 + h * 128 + 4 * q) = w; }
    }
}

template <bool OUT_BF16, int IN_BF16>
__device__ __forceinline__ void phase_ln(const void* inp, const void* inp2, const void* inp3, void* outp, const float* gam, const float* bet, const int row_lo, const int row_hi) {
    const int tid = opaque_tid(), wid = tid >> 6, lane = tid & 63;
    f32x4 gv[4], bv[4];
#pragma unroll
    for (int j = 0; j < 4; ++j) { gv[j] = *(const f32x4*)(gam + j * 256 + lane * 4); bv[j] = *(const f32x4*)(bet + j * 256 + lane * 4); }
    for (int row0 = row_lo + (blockIdx.x * 8 + wid) * 4; row0 < row_hi; row0 += gridDim.x * 32) {
        f32x4 v[4][4]; float s[4] = {0.f, 0.f, 0.f, 0.f}, s2[4] = {0.f, 0.f, 0.f, 0.f};
#pragma unroll
        for (int rr = 0; rr < 4; ++rr)
#pragma unroll
            for (int j = 0; j < 4; ++j) {
                if (IN_BF16 == 3) { const int row = row0 + rr; const float* xr = (row < T_PROMPT) ? (const float*)inp + (size_t)row * 1024 : (const float*)inp3 + (size_t)(row - T_PROMPT) * 1024;
                    const f32x4 xv = *(const f32x4*)(xr + lane * 4 + j * 256); const u32x2 fv = *(const u32x2*)((const bf16_t*)inp2 + (size_t)row * 1024 + lane * 4 + j * 256);
                    v[rr][j] = (f32x4){DN_ALPHA * xv[0] + bflo(fv.x), DN_ALPHA * xv[1] + bfhi(fv.x), DN_ALPHA * xv[2] + bflo(fv.y), DN_ALPHA * xv[3] + bfhi(fv.y)}; }
                else if (IN_BF16 == 2) { const u32x2 hv = *(const u32x2*)((const bf16_t*)inp + (size_t)(row0 + rr) * 1024 + lane * 4 + j * 256), fv = *(const u32x2*)((const bf16_t*)inp2 + (size_t)(row0 + rr) * 1024 + lane * 4 + j * 256);
                    v[rr][j] = (f32x4){DN_ALPHA * bflo(hv.x) + bflo(fv.x), DN_ALPHA * bfhi(hv.x) + bfhi(fv.x), DN_ALPHA * bflo(hv.y) + bflo(fv.y), DN_ALPHA * bfhi(hv.y) + bfhi(fv.y)}; }
                else if (IN_BF16 == 1) { const u32x2 hv = *(const u32x2*)((const bf16_t*)inp + (size_t)(row0 + rr) * 1024 + lane * 4 + j * 256); v[rr][j] = (f32x4){bflo(hv.x), bfhi(hv.x), bflo(hv.y), bfhi(hv.y)}; }
                else v[rr][j] = *(const f32x4*)((const float*)inp + (size_t)(row0 + rr) * 1024 + lane * 4 + j * 256); }
#pragma unroll
        for (int rr = 0; rr < 4; ++rr) {
#pragma unroll
            for (int j = 0; j < 4; ++j) s[rr] += (v[rr][j][0] + v[rr][j][1]) + (v[rr][j][2] + v[rr][j][3]);
#pragma unroll
            for (int o = 1; o < 64; o <<= 1) s[rr] += __shfl_xor(s[rr], o);
            const float mean = s[rr] * (1.f / 1024.f);
#pragma unroll
            for (int j = 0; j < 4; ++j) { v[rr][j] = v[rr][j] - mean; s2[rr] += (v[rr][j][0] * v[rr][j][0] + v[rr][j][1] * v[rr][j][1]) + (v[rr][j][2] * v[rr][j][2] + v[rr][j][3] * v[rr][j][3]); }
#pragma unroll
            for (int o = 1; o < 64; o <<= 1) s2[rr] += __shfl_xor(s2[rr], o);
            const float rstd = rsqrtf(s2[rr] * (1.f / 1024.f) + 1e-5f);
#pragma unroll
            for (int j = 0; j < 4; ++j) { const f32x4 y = v[rr][j] * rstd * gv[j] + bv[j];
                if (OUT_BF16) { u32x2 w; w.x = cvt_pk_bf16(y[0], y[1]); w.y = cvt_pk_bf16(y[2], y[3]); *(u32x2*)((bf16_t*)outp + (size_t)(row0 + rr) * 1024 + j * 256 + lane * 4) = w; }
                else *(f32x4*)((float*)outp + (size_t)(row0 + rr) * 1024 + j * 256 + lane * 4) = y; }
        }
    }
}

__device__ __forceinline__ void phase_ffnact(const Params& p) {
    const bf16_t* hdn = (const bf16_t*)(p.ws + OFF_HDN); bf16_t* act = (bf16_t*)(p.ws + OFF_ACT);
    const int total = 4096 * 352, nthr = gridDim.x * 512;
    for (int idx = blockIdx.x * 512 + opaque_tid(); idx < total; idx += nthr) {
        const int cgp = idx % 352, tblk = idx / 352, c0 = cgp * 8, t0 = tblk * 8, pos0 = t0 & (SEQL - 1);
        const bf16_t* hp = hdn + (size_t)t0 * 5632 + c0;
        const u32x4 zero4 = (u32x4){0u, 0u, 0u, 0u};
        u32x4 gr[10], vr[10];
#pragma unroll
        for (int rr = 0; rr < 10; ++rr) { const int pos = pos0 - 1 + rr; gr[rr] = zero4; vr[rr] = zero4;
            if (pos >= 0 && pos < SEQL) { gr[rr] = *(const u32x4*)(hp + (ptrdiff_t)(rr - 1) * 5632); vr[rr] = *(const u32x4*)(hp + (ptrdiff_t)(rr - 1) * 5632 + 2816); } }
        float wg_[3][8], wv_[3][8], bg[8], bv[8];
#pragma unroll
        for (int j = 0; j < 3; ++j) { const f32x4 a0 = *(const f32x4*)(p.fconvw + j * 5632 + c0), a1 = *(const f32x4*)(p.fconvw + j * 5632 + c0 + 4);
            const f32x4 b0 = *(const f32x4*)(p.fconvw + j * 5632 + 2816 + c0), b1 = *(const f32x4*)(p.fconvw + j * 5632 + 2816 + c0 + 4);
#pragma unroll
            for (int e = 0; e < 4; ++e) { wg_[j][e] = a0[e]; wg_[j][4 + e] = a1[e]; wv_[j][e] = b0[e]; wv_[j][4 + e] = b1[e]; } }
        { const f32x4 a0 = *(const f32x4*)(p.fconvb + c0), a1 = *(const f32x4*)(p.fconvb + c0 + 4), b0 = *(const f32x4*)(p.fconvb + 2816 + c0), b1 = *(const f32x4*)(p.fconvb + 2816 + c0 + 4);
#pragma unroll
          for (int e = 0; e < 4; ++e) { bg[e] = a0[e]; bg[4 + e] = a1[e]; bv[e] = b0[e]; bv[4 + e] = b1[e]; } }
#pragma unroll
        for (int tt = 0; tt < 8; ++tt) {
            const unsigned gpa[4] = {gr[tt].x, gr[tt].y, gr[tt].z, gr[tt].w}, gca[4] = {gr[tt + 1].x, gr[tt + 1].y, gr[tt + 1].z, gr[tt + 1].w}, gna[4] = {gr[tt + 2].x, gr[tt + 2].y, gr[tt + 2].z, gr[tt + 2].w};
            const unsigned vpa[4] = {vr[tt].x, vr[tt].y, vr[tt].z, vr[tt].w}, vca[4] = {vr[tt + 1].x, vr[tt + 1].y, vr[tt + 1].z, vr[tt + 1].w}, vna[4] = {vr[tt + 2].x, vr[tt + 2].y, vr[tt + 2].z, vr[tt + 2].w};
            float y[8];
#pragma unroll
            for (int q = 0; q < 4; ++q) {
                const float G0 = wg_[0][2 * q] * bflo(gpa[q]) + wg_[1][2 * q] * bflo(gca[q]) + wg_[2][2 * q] * bflo(gna[q]) + bg[2 * q];
                const float G1 = wg_[0][2 * q + 1] * bfhi(gpa[q]) + wg_[1][2 * q + 1] * bfhi(gca[q]) + wg_[2][2 * q + 1] * bfhi(gna[q]) + bg[2 * q + 1];
                const float V0 = wv_[0][2 * q] * bflo(vpa[q]) + wv_[1][2 * q] * bflo(vca[q]) + wv_[2][2 * q] * bflo(vna[q]) + bv[2 * q];
                const float V1 = wv_[0][2 * q + 1] * bfhi(vpa[q]) + wv_[1][2 * q + 1] * bfhi(vca[q]) + wv_[2][2 * q + 1] * bfhi(vna[q]) + bv[2 * q + 1];
                y[2 * q] = silu_f(G0) * V0; y[2 * q + 1] = silu_f(G1) * V1; }
            u32x4 w; w.x = cvt_pk_bf16(y[0], y[1]); w.y = cvt_pk_bf16(y[2], y[3]); w.z = cvt_pk_bf16(y[4], y[5]); w.w = cvt_pk_bf16(y[6], y[7]);
            *(u32x4*)(act + (size_t)(t0 + tt) * 2816 + c0) = w;
        }
    }
}

#define XB_TMO      128
#define XB_XCNT(j)  (256  + 64 * (j))
#define XB_XSUB(j)  (1280 + 64 * (j))
#define XB_XGEN(j)  (2304 + 64 * (j))
#define XB_TOP      3328
#define XB_TOPGEN   3392
#define XCD_BAR_WORDS 3456
#define XB_SPIN_CAP (1u << 20)
__device__ __forceinline__ unsigned xb_ld(unsigned* p)              { return __hip_atomic_load(p, __ATOMIC_RELAXED, __HIP_MEMORY_SCOPE_AGENT); }
__device__ __forceinline__ unsigned xb_add(unsigned* p, unsigned v) { return __hip_atomic_fetch_add(p, v, __ATOMIC_RELAXED, __HIP_MEMORY_SCOPE_AGENT); }
__device__ __forceinline__ unsigned xb_xcc_id() { return (unsigned)__builtin_amdgcn_s_getreg((3 << 11) | 20) & 0xFu; }
#define XB_SPIN(cond, bar) do { unsigned _sp = 0; while (cond) { __builtin_amdgcn_s_sleep(1); \
    if ((++_sp & 255u) == 0u) { if (xb_ld(&(bar)[XB_TMO])) break; if (_sp > XB_SPIN_CAP) { atomicAdd(&(bar)[XB_TMO], 1u); break; } } } } while (0)
struct XcdBarrier { unsigned* bar; unsigned x; volatile LAS unsigned* st; };
__device__ __forceinline__ XcdBarrier xcd_barrier_post(unsigned* bar, volatile LAS unsigned* st) {
    XcdBarrier b; b.bar = bar; b.x = xb_xcc_id(); b.st = st;
    if (threadIdx.x == 0) (void)xb_add(&bar[XB_XCNT(b.x)], 1u);
    return b;
}
__device__ __forceinline__ void xcd_barrier_complete(unsigned* bar, unsigned x, unsigned& nloc, unsigned& nx) {
    const unsigned G = gridDim.x * gridDim.y * gridDim.z;
    unsigned sum, cnt, mine, sp = 0u;
    for (;;) {
        sum = 0u; cnt = 0u; mine = 0u;
#pragma unroll
        for (unsigned j = 0; j < 16; ++j) { const unsigned c = xb_ld(&bar[XB_XCNT(j)]); sum += c; cnt += (c > 0u) ? 1u : 0u; mine = (j == x) ? c : mine; }
        if (sum == G) break;
        __builtin_amdgcn_s_sleep(1);
        if ((++sp & 255u) == 0u) { if (xb_ld(&bar[XB_TMO])) break; if (sp > XB_SPIN_CAP) { atomicAdd(&bar[XB_TMO], 1u); break; } }
    }
    nloc = mine > 0u ? mine : 1u; nx = cnt > 0u ? cnt : 1u;
}
__device__ __forceinline__ void xcd_barrier(const XcdBarrier& b) {
    asm volatile("s_waitcnt vmcnt(0)" ::: "memory");
    __syncthreads();
    if (threadIdx.x == 0) {
        unsigned* bar = b.bar;
        __builtin_amdgcn_s_waitcnt(0);
        unsigned nloc = b.st[0], nx = b.st[1];
        if (nloc == 0u) { xcd_barrier_complete(bar, b.x, nloc, nx); b.st[0] = nloc; b.st[1] = nx; }
        const unsigned old = xb_add(&bar[XB_XSUB(b.x)], 1u);
        const unsigned gen = old / nloc;
        if (old + 1u == (gen + 1u) * nloc) {
            __builtin_amdgcn_fence(__ATOMIC_RELEASE, "agent");
            asm volatile("s_waitcnt vmcnt(0)" ::: "memory");
            const unsigned og = xb_add(&bar[XB_TOP], 1u);
            const unsigned tg = og / nx;
            if (og + 1u == (tg + 1u) * nx) xb_add(&bar[XB_TOPGEN], 1u);
            else XB_SPIN(xb_ld(&bar[XB_TOPGEN]) == tg, bar);
            __builtin_amdgcn_fence(__ATOMIC_ACQUIRE, "agent");
            xb_add(&bar[XB_XGEN(b.x)], 1u);
            asm volatile("s_waitcnt vmcnt(0)" ::: "memory");
        } else {
            XB_SPIN(xb_ld(&bar[XB_XGEN(b.x)]) == gen, bar);
            __builtin_amdgcn_fence(__ATOMIC_ACQUIRE, "agent");
            asm volatile("s_waitcnt vmcnt(0)" ::: "memory");
        }
    }
    __syncthreads();
}


__device__ __forceinline__ void ffn_up(const Params& p, const int fg, LAS unsigned char* lds, pg8::StaticOrder& S) {
    pg8::Gemm g{(const bf16_t*)(p.ws + OFF_X1) + (size_t)fg * 32768 * 1024, (const bf16_t*)(p.ws + OFF_WUP), 32768, 5632, 1024};
    pg8::EpiBf16 E{(bf16_t*)(p.ws + OFF_HDN), 5632};
    S.init(g.M, g.N, gridDim.x, blockIdx.x); pg8::gemm_phase(lds, g, S, E);
}
__device__ __forceinline__ void ffn_down(const Params& p, const int fg, LAS unsigned char* lds, pg8::StaticOrder& S) {
    pg8::Gemm g{(const bf16_t*)(p.ws + OFF_ACT), (const bf16_t*)(p.ws + OFF_WDOWN), 32768, 1024, 2816};
    pg8::EpiBf16 E{(bf16_t*)(p.ws + OFF_FFNB) + (size_t)fg * 32768 * 1024, 1024};
    S.init(g.M, g.N, gridDim.x, blockIdx.x); pg8::gemm_phase(lds, g, S, E);
}
#ifndef ONLY
#define ONLY -1
#endif
#define EN(k) (ONLY < 0 || ONLY == (k))
constexpr int N_STEPS = 18;
#ifndef DUP_MASK
#define DUP_MASK 0
#endif
__device__ __forceinline__ void run_step(const Params& p, int step, unsigned char* smem) {
    LAS unsigned char* lds = (LAS unsigned char*)smem;
    pg8::StaticOrder S;
    switch (step) {
    case 0: if (EN(0)) { phase_wprep(p, smem, 0, blockIdx.x, gridDim.x); phase_xconv(p, smem); } break;
    case 1: if (EN(1)) {
        const bf16_t* xb = (const bf16_t*)(p.ws + OFF_XB); const bf16_t* wm = (const bf16_t*)(p.ws + OFF_WMAIN);
        { pg8::Gemm g{xb, wm, T_TOK, 1536, 1024}; pg8::EpiBf16 E{(bf16_t*)(p.ws + OFF_SEG), 1536};
          S.init(g.M, g.N, gridDim.x, blockIdx.x); pg8::gemm_phase(lds, g, S, E); }
        { pg8::Gemm g{xb, wm + (size_t)1536 * 1024, T_TOK, 1024, 1024}; pg8::EpiNAqk E{(bf16_t*)(p.ws + OFF_NA2)};
          S.init(g.M, g.N, gridDim.x, blockIdx.x); pg8::gemm_phase(lds, g, S, E); }
        { pg8::Gemm g{xb, wm + (size_t)2560 * 1024, T_TOK, 512, 1024}; pg8::EpiBf16 E{(bf16_t*)((unsigned char*)p.out + OOFF_Z), 512};
          S.init(g.M, g.N, gridDim.x, blockIdx.x); pg8::gemm_phase(lds, g, S, E); }
        { pg8::Gemm g{(const bf16_t*)(p.ws + OFF_WV), xb, 512, T_TOK, 1024}; pg8::EpiVT E{(bf16_t*)(p.ws + OFF_VT)};
          S.init(g.M, g.N, gridDim.x, blockIdx.x); pg8::gemm_phase(lds, g, S, E); }
    } break;
    case 2: if (EN(2)) phase_na(p, smem); break;
    case 3: if (EN(3)) phase_prep(p, 0, smem); break;
    case 4: if (EN(4)) { phase_scan(p, 0, smem);
              if (gridDim.x > 192) { if (blockIdx.x >= 192) phase_wprep(p, smem, 1, blockIdx.x - 192, gridDim.x - 192); }
              else phase_wprep(p, smem, 1, blockIdx.x, gridDim.x); } break;
    case 5: if (EN(5)) { for (int k = 0; k < 2; ++k) { if ((k == 0) != ((blockIdx.x & 1) != 0)) phase_combine(p, 0); else phase_prep(p, 1, smem); __syncthreads(); } } break;
    case 6: if (EN(4)) { phase_scan(p, 1, smem);
              if (gridDim.x > 192) { if (blockIdx.x >= 192) phase_wprep(p, smem, 2, blockIdx.x - 192, gridDim.x - 192); }
              else phase_wprep(p, smem, 2, blockIdx.x, gridDim.x); } break;
    case 7: if (EN(5)) phase_combine(p, 1); break;
    case 8: if (EN(8)) { pg8::Gemm g{(const bf16_t*)(p.ws + OFF_MIX), (const bf16_t*)(p.ws + OFF_WOUT), T_TOK, 1024, 1024};
              pg8::EpiBf16 E{(bf16_t*)(p.ws + OFF_H1), 1024};
              S.init(g.M, g.N, gridDim.x, blockIdx.x); pg8::gemm_phase(lds, g, S, E); } break;
    case 9: if (EN(9)) phase_ln<true, 3>(p.xp, p.ws + OFF_H1, p.xs, p.ws + OFF_X1, p.ln1g, p.ln1b, 0, T_TOK); break;
    case 10: if (EN(10)) ffn_up(p, 0, lds, S); break;
    case 11: case 13: case 15: if (EN(11)) phase_ffnact(p); break;
    case 12: if (EN(12)) { ffn_down(p, 0, lds, S); ffn_up(p, 1, lds, S); } break;
    case 14: case 16: if (EN(12)) {
              const int fg = (step - 12) / 2;
              for (int k = 0; k < 2; ++k) {
                  if ((k == 0) != ((blockIdx.x & 1) != 0)) phase_ln<false, 2>(p.ws + OFF_X1, p.ws + OFF_FFNB, nullptr, p.out, p.ln2g, p.ln2b, (fg - 1) * 32768, fg * 32768);
                  else { ffn_down(p, fg, lds, S); if (fg < 2) ffn_up(p, fg + 1, lds, S); }
                  __syncthreads(); } } break;
    case 17: if (EN(9)) phase_ln<false, 2>(p.ws + OFF_X1, p.ws + OFF_FFNB, nullptr, p.out, p.ln2g, p.ln2b, 65536, T_TOK); break;
    default: break;
    }
}

template <bool COOP>
__global__ void __launch_bounds__(512, 2) mega(Params p, int s0, int s1) {
    extern __shared__ __attribute__((aligned(16))) unsigned char smem[];
    XcdBarrier xb;
    if (COOP) {
        volatile LAS unsigned* st = (volatile LAS unsigned*)((LAS unsigned char*)smem + LDS_BAR_OFF);
        if (threadIdx.x == 0) { st[0] = 0u; st[1] = 0u; }
        __syncthreads();
        xb = xcd_barrier_post((unsigned*)(p.ws + OFF_BAR), st);
    }
    for (int s = s0; s < s1; ++s) {
        const int nrep = 1 + ((DUP_MASK >> s) & 1);
        for (int rep = 0; rep < nrep; ++rep) {
            int lofs = 0; asm volatile("" : "+s"(lofs));
            run_step(p, s, smem + lofs);
            if (COOP) { if (s + 1 < s1 || rep + 1 < nrep) { if (s0 < 0) cg::this_grid().sync(); else xcd_barrier(xb); } }
            else __syncthreads();
        }
    }
}

extern "C" void kernel_launch(void* const* d_in, const int* in_sizes, int n_in, void* d_out, int out_size, void* d_ws, size_t ws_size, hipStream_t stream) {
    static int grid = 0;
    if (grid == 0) {
        if (n_in != 17 || ws_size < WS_NEED || out_size != T_TOK * 1024) { fprintf(stderr, "kernel_launch: unexpected shapes (n_in %d ws %zu out %d)\n", n_in, ws_size, out_size); grid = -1; return; }
        int dev = 0, cus = 0, per_cu = 0;
        hipGetDevice(&dev); hipDeviceGetAttribute(&cus, hipDeviceAttributeMultiprocessorCount, dev);
        hipFuncSetAttribute((const void*)mega<true>, hipFuncAttributeMaxDynamicSharedMemorySize, LDS_BYTES);
        hipFuncSetAttribute((const void*)mega<false>, hipFuncAttributeMaxDynamicSharedMemorySize, LDS_BYTES);
        hipOccupancyMaxActiveBlocksPerMultiprocessor(&per_cu, (const void*)mega<true>, 512, LDS_BYTES);
        if (per_cu < 1) { fprintf(stderr, "kernel_launch: occupancy query says %d blocks/CU\n", per_cu); per_cu = 1; }
        (void)hipGetLastError();
        grid = cus;
    }
    if (grid < 0) return;
    Params p{};
    p.xp = (const float*)d_in[0]; p.xs = (const float*)d_in[1]; p.w_in = (const float*)d_in[2]; p.rpb = (const float*)d_in[3]; p.gconv = (const float*)d_in[4];
    p.a_log = (const float*)d_in[5]; p.dt_bias = (const float*)d_in[6]; p.gnorm = (const float*)d_in[7]; p.w_out = (const float*)d_in[8]; p.ln1g = (const float*)d_in[9];
    p.ln1b = (const float*)d_in[10]; p.w_up = (const float*)d_in[11]; p.fconvw = (const float*)d_in[12]; p.fconvb = (const float*)d_in[13]; p.w_down = (const float*)d_in[14];
    p.ln2g = (const float*)d_in[15]; p.ln2b = (const float*)d_in[16]; p.out = (float*)d_out; p.ws = (unsigned char*)d_ws;
#if ONE_LAUNCH
    if (hipMemsetAsync((unsigned char*)d_ws + OFF_BAR, 0, XCD_BAR_WORDS * sizeof(unsigned), stream) != hipSuccess) { fprintf(stderr, "kernel_launch: memset of barrier words failed\n"); return; }
    int s0 = 0, s1 = N_STEPS;
    void* args[] = {&p, &s0, &s1};
    hipError_t e = hipLaunchCooperativeKernel((const void*)mega<true>, dim3(grid), dim3(512), args, LDS_BYTES, stream);
    if (e != hipSuccess) fprintf(stderr, "cooperative launch failed: %s (grid %d)\n", hipGetErrorString(e), grid);
#else
    for (int s = 0; s < N_STEPS; ++s) hipLaunchKernelGGL(mega<false>, dim3(grid), dim3(512), LDS_BYTES, stream, p, s, s + 1);
#endif
}
```

```cpp
#include <hip/hip_runtime.h>
#include <hip/hip_cooperative_groups.h>
#include <cstdio>
namespace cg = cooperative_groups;

#define LAS __attribute__((address_space(3)))
typedef unsigned short bf16_t;
typedef short bf16x8 __attribute__((ext_vector_type(8)));
typedef float f32x4 __attribute__((ext_vector_type(4)));
typedef unsigned u32x4 __attribute__((ext_vector_type(4)));
typedef unsigned u32x2 __attribute__((ext_vector_type(2)));

#ifndef ONE_LAUNCH
#define ONE_LAUNCH 1
#endif

constexpr int T_TOK = 98304, T_PROMPT = 32768, SEQL = 2048;
constexpr size_t MiB = (size_t)1 << 20;
constexpr size_t OFF_WMAIN = 0, OFF_WV = 6 * MiB, OFF_WG = 7 * MiB, OFF_WOUT = 8 * MiB, OFF_WUP = 10 * MiB, OFF_WDOWN = 21 * MiB, OFF_CD = 27 * MiB,
                 OFF_XB = 28 * MiB, OFF_MIX = 28 * MiB, OFF_SEG = 220 * MiB, OFF_NA2 = 508 * MiB, OFF_VT = 700 * MiB, OFF_PREP = 508 * MiB, OFF_H1 = 220 * MiB,
                 OFF_X1 = 604 * MiB, OFF_FFNB = 796 * MiB, OFF_HDN = 28 * MiB, OFF_ACT = 380 * MiB, WS_NEED = 1024 * MiB;
constexpr size_t SEG_ELEMS = (size_t)T_TOK * 512;
constexpr size_t OOFF_O = 0, OOFF_GATES = 192 * MiB, OOFF_Z = 198 * MiB;
constexpr int PREP_ITEM = 73728;
constexpr int PI_W = 0, PI_QD = 16384, PI_ATTN = 32768, PI_KDT = 40960, PI_UT = 57344;
constexpr int LDS_BAR_OFF = 155648, LDS_BYTES = LDS_BAR_OFF + 16;
constexpr size_t OFF_BAR = 27 * MiB + 512 * 1024;
constexpr float DN_ALPHA = 1.189207115002721f;

struct Params {
    const float* xp; const float* xs; const float* w_in; const float* rpb; const float* gconv; const float* a_log; const float* dt_bias; const float* gnorm;
    const float* w_out; const float* ln1g; const float* ln1b; const float* w_up; const float* fconvw; const float* fconvb; const float* w_down;
    const float* ln2g; const float* ln2b; float* out; unsigned char* ws;
};

__device__ __forceinline__ int opaque_tid() { int t = threadIdx.x; asm volatile("" : "+v"(t)); return t; }
typedef float f32x2_t __attribute__((ext_vector_type(2)));
typedef __bf16 bf16x2_t __attribute__((ext_vector_type(2)));
__device__ __forceinline__ unsigned cvt_pk_bf16(float lo, float hi) { const f32x2_t v = {lo, hi}; union { bf16x2_t b; unsigned u; } c; c.b = __builtin_convertvector(v, bf16x2_t); return c.u; }
__device__ __forceinline__ float bflo(unsigned u) { return __uint_as_float(u << 16); }
__device__ __forceinline__ float bfhi(unsigned u) { return __uint_as_float(u & 0xffff0000u); }
__device__ __forceinline__ float bf2f(bf16_t b) { return __uint_as_float(((unsigned)b) << 16); }
__device__ __forceinline__ bf16_t f2bf(float f) { return (bf16_t)(cvt_pk_bf16(f, 0.f) & 0xffffu); }
__device__ __forceinline__ float silu_f(float x) { return x * __builtin_amdgcn_rcpf(1.f + __expf(-x)); }
__device__ __forceinline__ float sigmoid_f(float x) { return __builtin_amdgcn_rcpf(1.f + __expf(-x)); }
__device__ __forceinline__ const float* xrow(const Params& p, int row) { return row < T_PROMPT ? p.xp + (size_t)row * 1024 : p.xs + (size_t)(row - T_PROMPT) * 1024; }
__device__ __forceinline__ bf16x8 as_bf16x8(u32x4 v) { union { u32x4 u; bf16x8 b; } c; c.u = v; return c.b; }
__device__ __forceinline__ int perm_k(int c) { return (c & ~31) | (((c >> 2) & 3) << 3) | (((c >> 4) & 1) << 2) | (c & 3); }

namespace pg8 {
constexpr int BM = 256, BK = 64, HALF = 128, HTB = HALF * BK * 2, STAGE_BYTES = 8 * HTB, NXCD = 8, WGM = 8;
__host__ __device__ __forceinline__ int lds_byte(int r, int c) { const int st = (r >> 4) * 2 + (c >> 5), rr = r & 15, cc = c & 31, ob = rr * 64 + cc * 2; return st * 1024 + (ob ^ (((ob >> 9) & 1) << 5)); }
__host__ __device__ __forceinline__ void stage_rc(int b, int& R, int& C) { const int st = b / 1024, sb = b % 1024, swz = sb ^ (((sb >> 9) & 1) << 5); R = (st >> 1) * 16 + swz / 64; C = (st & 1) * 32 + (swz % 64) / 2; }
__host__ __device__ __forceinline__ int perm32(int rho) { const int n = rho >> 4, i = rho & 15; return 8 * (i >> 2) + 4 * n + (i & 3); }
struct Unit { int pm, pn; };
struct Gemm { const bf16_t* A; const bf16_t* Bt; int M, N, K; };
struct StaticOrder {
    int nM, nN, nwg, G, c;
    __device__ void init(int M, int N, int G_, int c_) { nM = M / BM; nN = N / BM; nwg = nM * nN; G = G_; c = c_; }
    __device__ bool next(int i, Unit& u) const {
        const long L = (long)i * G + c; if (L >= nwg) return false;
        int wgid = (int)L; { const int q = nwg / NXCD, r = nwg % NXCD, xcd = wgid % NXCD, off = wgid / NXCD; wgid = (xcd < r ? xcd * (q + 1) : r * (q + 1) + (xcd - r) * q) + off; }
        const int nig = WGM * nN, gid = wgid / nig, fm = gid * WGM, gsz = (nM - fm) < WGM ? (nM - fm) : WGM;
        u.pm = fm + ((wgid % nig) % gsz); u.pn = (wgid % nig) / gsz; return true;
    }
};

template <class Epi>
__device__ __forceinline__ void gemm_phase(LAS unsigned char* lds, const Gemm g, const StaticOrder& S, const Epi& E) {
    const int tid = opaque_tid(), wid = __builtin_amdgcn_readfirstlane(tid >> 6), lane = tid & 63, wr = wid >> 2, wc = wid & 3, fr = lane & 15, fq = lane >> 4;
    const int K = g.K, nt = K / BK;
    unsigned voffA[2], voffB[2];
#pragma unroll
    for (int i = 0; i < 2; ++i) { int R, C; stage_rc(tid * 16 + i * 8192, R, C); const int Rb = Epi::PERM ? ((R & ~31) + perm32(R & 31)) : R;
        voffA[i] = (unsigned)(R * K + C) * 2u; voffB[i] = (unsigned)(Rb * K + C) * 2u; }
    const size_t kstep = (size_t)(BK * 2);
    const size_t hstep = (size_t)HALF * K * 2;
    const size_t tstep = 2 * hstep;
    const unsigned ldsw = (unsigned)wid * 1024u;
    const int aoff = lds_byte(wr * 64 + fr, fq * 8), boff = lds_byte(wc * 32 + fr, fq * 8);
#define PG8_SA(b, h) (((b) * 2 + (h)) * HTB)
#define PG8_SB(b, h) ((4 + (b) * 2 + (h)) * HTB)
#define PG8_STAGE(bufoff, gbase, voff) do { _Pragma("unroll") for (int _i = 0; _i < 2; ++_i) \
        __builtin_amdgcn_global_load_lds((const unsigned*)((const char*)(gbase) + (voff)[_i]), (LAS unsigned*)(lds + (bufoff) + ldsw + _i * 8192), 16, 0, 0); } while (0)
#define PG8_LDA(dst, b, h) do { _Pragma("unroll") for (int m = 0; m < 4; ++m) _Pragma("unroll") for (int k = 0; k < 2; ++k) dst[m][k] = *(const LAS bf16x8*)(lds + PG8_SA(b, h) + aoff + m * 2048 + k * 1024); } while (0)
#define PG8_LDB(dst, b, h) do { _Pragma("unroll") for (int n = 0; n < 2; ++n) _Pragma("unroll") for (int k = 0; k < 2; ++k) dst[n][k] = *(const LAS bf16x8*)(lds + PG8_SB(b, h) + boff + n * 2048 + k * 1024); } while (0)
#define PG8_MMA(ai, bj, At, Bt) do { __builtin_amdgcn_s_setprio(1); _Pragma("unroll") for (int m = 0; m < 4; ++m) _Pragma("unroll") for (int n = 0; n < 2; ++n) _Pragma("unroll") for (int k = 0; k < 2; ++k) \
        acc[ai][bj][m][n] = __builtin_amdgcn_mfma_f32_16x16x32_bf16(Bt[n][k], At[m][k], acc[ai][bj][m][n], 0, 0, 0); __builtin_amdgcn_s_setprio(0); } while (0)
#define PG8_WAIT_V(n) asm volatile("s_waitcnt vmcnt(" #n ")" ::: "memory")
#define PG8_WAIT_L(n) asm volatile("s_waitcnt lgkmcnt(" #n ")" ::: "memory")
#define PG8_BAR __builtin_amdgcn_s_barrier()
#define PG8_SCHED __builtin_amdgcn_sched_barrier(0)
    Unit cur, nxt; int ui = 0;
    if (!S.next(0, cur)) return;
    f32x4 acc[2][2][4][2];
#pragma unroll
    for (int a = 0; a < 2; ++a)
#pragma unroll
        for (int b = 0; b < 2; ++b)
#pragma unroll
            for (int m = 0; m < 4; ++m)
#pragma unroll
                for (int n = 0; n < 2; ++n) acc[a][b][m][n] = (f32x4){0.f, 0.f, 0.f, 0.f};
    bf16x8 At[4][2], B0[2][2], B1[2][2];
    const char* cA = (const char*)g.A + (size_t)cur.pm * tstep; const char* cB = (const char*)g.Bt + (size_t)cur.pn * tstep;
    PG8_STAGE(PG8_SB(0, 0), cB, voffB); PG8_STAGE(PG8_SA(0, 0), cA, voffA); PG8_STAGE(PG8_SB(0, 1), cB + hstep, voffB); PG8_STAGE(PG8_SA(0, 1), cA + hstep, voffA);
    if (wr == 1) PG8_BAR;
    PG8_WAIT_V(4); PG8_BAR;
    PG8_STAGE(PG8_SB(1, 0), cB + kstep, voffB); PG8_STAGE(PG8_SA(1, 0), cA + kstep, voffA); PG8_STAGE(PG8_SB(1, 1), cB + hstep + kstep, voffB);
    PG8_WAIT_V(6); PG8_BAR;
    for (;;) {
        const bool has_next = S.next(ui + 1, nxt);
        const char* nA = has_next ? (const char*)g.A + (size_t)nxt.pm * tstep : cA; const char* nB = has_next ? (const char*)g.Bt + (size_t)nxt.pn * tstep : cB;
        for (int t = 0; t < nt; t += 2) {
            const bool last = (t == nt - 2);
            const char* a1 = cA + (size_t)(t + 1) * kstep;
            const char* a2 = last ? nA : cA + (size_t)(t + 2) * kstep; const char* b2 = last ? nB : cB + (size_t)(t + 2) * kstep;
            const char* a3 = a2 + kstep; const char* b3 = b2 + kstep;
            PG8_LDB(B0, 0, 0); PG8_SCHED; PG8_LDA(At, 0, 0); PG8_STAGE(PG8_SA(1, 1), a1 + hstep, voffA);
            PG8_WAIT_L(8); PG8_BAR; PG8_WAIT_L(0); PG8_MMA(0, 0, At, B0); PG8_BAR; PG8_SCHED;
            PG8_LDB(B1, 0, 1); PG8_STAGE(PG8_SB(0, 0), b2, voffB);
            PG8_BAR; PG8_WAIT_L(0); PG8_MMA(0, 1, At, B1); PG8_BAR;
            PG8_LDA(At, 0, 1); PG8_STAGE(PG8_SA(0, 0), a2, voffA);
            PG8_BAR; PG8_WAIT_L(0); PG8_MMA(1, 0, At, B0); PG8_BAR; PG8_SCHED;
            PG8_STAGE(PG8_SB(0, 1), b2 + hstep, voffB);
            PG8_WAIT_V(6); PG8_BAR; PG8_MMA(1, 1, At, B1); PG8_BAR;
            PG8_LDB(B0, 1, 0); PG8_SCHED; PG8_LDA(At, 1, 0); PG8_STAGE(PG8_SA(0, 1), a2 + hstep, voffA);
            PG8_WAIT_L(8); PG8_BAR; PG8_WAIT_L(0); PG8_MMA(0, 0, At, B0); PG8_BAR; PG8_SCHED;
            PG8_LDB(B1, 1, 1); PG8_STAGE(PG8_SB(1, 0), b3, voffB);
            PG8_BAR; PG8_WAIT_L(0); PG8_MMA(0, 1, At, B1); PG8_BAR;
            PG8_LDA(At, 1, 1); PG8_STAGE(PG8_SA(1, 0), a3, voffA);
            PG8_BAR; PG8_WAIT_L(0); PG8_MMA(1, 0, At, B0); PG8_BAR; PG8_SCHED;
            PG8_STAGE(PG8_SB(1, 1), b3 + hstep, voffB);
            PG8_WAIT_V(6); PG8_BAR; PG8_MMA(1, 1, At, B1); PG8_BAR;
        }
        E(acc, cur, wr, wc, fr, fq);
        if (!has_next) break;
#pragma unroll
        for (int a = 0; a < 2; ++a)
#pragma unroll
            for (int b = 0; b < 2; ++b)
#pragma unroll
                for (int m = 0; m < 4; ++m)
#pragma unroll
                    for (int n = 0; n < 2; ++n) acc[a][b][m][n] = (f32x4){0.f, 0.f, 0.f, 0.f};
        cur = nxt; cA = nA; cB = nB; ++ui;
    }
    PG8_WAIT_V(0);
    if (wr == 0) PG8_BAR;
    PG8_BAR;
#undef PG8_SA
#undef PG8_SB
#undef PG8_STAGE
#undef PG8_LDA
#undef PG8_LDB
#undef PG8_MMA
#undef PG8_WAIT_V
#undef PG8_WAIT_L
#undef PG8_BAR
#undef PG8_SCHED
}

struct EpiBf16 {
    static constexpr bool PERM = true;
    bf16_t* O; int ldc;
    __device__ __forceinline__ void operator()(const f32x4 (&acc)[2][2][4][2], const Unit& u, int wr, int wc, int fr, int fq) const {
        const int row0 = u.pm * BM + wr * 64 + fr, col0 = u.pn * BM + wc * 32 + 8 * fq; bf16_t* base = O;
#pragma unroll
        for (int ai = 0; ai < 2; ++ai)
#pragma unroll
            for (int m = 0; m < 4; ++m) { bf16_t* rowp = base + (size_t)(row0 + ai * HALF + m * 16) * ldc + col0;
#pragma unroll
                for (int bj = 0; bj < 2; ++bj) { const f32x4 v0 = acc[ai][bj][m][0], v1 = acc[ai][bj][m][1];
                    u32x4 w; w.x = cvt_pk_bf16(v0[0], v0[1]); w.y = cvt_pk_bf16(v0[2], v0[3]); w.z = cvt_pk_bf16(v1[0], v1[1]); w.w = cvt_pk_bf16(v1[2], v1[3]);
                    *(u32x4*)(rowp + bj * HALF) = w; } }
    }
};
struct EpiNAqk {
    static constexpr bool PERM = true;
    bf16_t* O;
    __device__ __forceinline__ void operator()(const f32x4 (&acc)[2][2][4][2], const Unit& u, int wr, int wc, int fr, int fq) const {
        const int row0 = u.pm * BM + wr * 64 + fr;
#pragma unroll
        for (int ai = 0; ai < 2; ++ai)
#pragma unroll
            for (int m = 0; m < 4; ++m) { const int tok = row0 + ai * HALF + m * 16;
#pragma unroll
                for (int bj = 0; bj < 2; ++bj) { const int hh = u.pn * 4 + bj * 2 + (wc >> 1);
                    bf16_t* dst = O + (size_t)hh * ((size_t)T_TOK * 64) + (size_t)(tok >> 3) * 512 + (wc & 1) * 256 + (tok & 7) * 32 + fq * 8;
                    const f32x4 v0 = acc[ai][bj][m][0], v1 = acc[ai][bj][m][1];
                    u32x4 w; w.x = cvt_pk_bf16(v0[0], v0[1]); w.y = cvt_pk_bf16(v0[2], v0[3]); w.z = cvt_pk_bf16(v1[0], v1[1]); w.w = cvt_pk_bf16(v1[2], v1[3]);
                    *(u32x4*)dst = w; } }
    }
};
struct EpiVT {
    static constexpr bool PERM = true;
    bf16_t* O;
    __device__ __forceinline__ void operator()(const f32x4 (&acc)[2][2][4][2], const Unit& u, int wr, int wc, int fr, int fq) const {
        const int row0 = u.pm * BM + wr * 64 + fr, col0 = u.pn * BM + wc * 32 + 8 * fq;
#pragma unroll
        for (int ai = 0; ai < 2; ++ai)
#pragma unroll
            for (int m = 0; m < 4; ++m) { const int f = row0 + ai * HALF + m * 16;
                bf16_t* fb = O + (size_t)(f >> 6) * ((size_t)T_TOK * 64) + (f & 63) * 4;
#pragma unroll
                for (int bj = 0; bj < 2; ++bj)
#pragma unroll
                    for (int n = 0; n < 2; ++n) { const f32x4 v = acc[ai][bj][m][n];
                        u32x2 w; w.x = cvt_pk_bf16(v[0], v[1]); w.y = cvt_pk_bf16(v[2], v[3]);
                        *(u32x2*)(fb + (size_t)(((col0 + bj * HALF) >> 2) + n) * 256) = w; } }
    }
};
template <bool RES_BF16> struct EpiRes {
    static constexpr bool PERM = false;
    float* C; const void* res0; const void* res1; int split_row; float alpha;
    __device__ __forceinline__ void operator()(const f32x4 (&acc)[2][2][4][2], const Unit& u, int wr, int wc, int fr, int fq) const {
        const int row0 = u.pm * BM + wr * 64 + fr, col0 = u.pn * BM + wc * 32 + 4 * fq;
#pragma unroll
        for (int ai = 0; ai < 2; ++ai)
#pragma unroll
            for (int m = 0; m < 4; ++m) { const int row = row0 + ai * HALF + m * 16; float* rowp = C + (size_t)row * 1024 + col0;
                const size_t roff = (row < split_row) ? (size_t)row * 1024 : (size_t)(row - split_row) * 1024; const void* rb = (row < split_row) ? res0 : res1;
#pragma unroll
                for (int bj = 0; bj < 2; ++bj)
#pragma unroll
                    for (int n = 0; n < 2; ++n) { const int co = bj * HALF + n * 16; f32x4 r;
                        if (RES_BF16) { const u32x2 rv = *(const u32x2*)((const bf16_t*)rb + roff + col0 + co); r = (f32x4){bflo(rv.x), bfhi(rv.x), bflo(rv.y), bfhi(rv.y)}; }
                        else r = *(const f32x4*)((const float*)rb + roff + col0 + co);
                        *(f32x4*)(rowp + co) = acc[ai][bj][m][n] + alpha * r; } }
    }
};
struct EpiResToBf16 {
    static constexpr bool PERM = true;
    bf16_t* H; const float* x0; const float* x1; int split_row; float alpha;
    __device__ __forceinline__ void operator()(const f32x4 (&acc)[2][2][4][2], const Unit& u, int wr, int wc, int fr, int fq) const {
        const int row0 = u.pm * BM + wr * 64 + fr, col0 = u.pn * BM + wc * 32 + 8 * fq;
#pragma unroll
        for (int ai = 0; ai < 2; ++ai)
#pragma unroll
            for (int m = 0; m < 4; ++m) { const int row = row0 + ai * HALF + m * 16;
                const float* xr = ((row < split_row) ? x0 + (size_t)row * 1024 : x1 + (size_t)(row - split_row) * 1024) + col0;
#pragma unroll
                for (int bj = 0; bj < 2; ++bj) { const f32x4 xa = *(const f32x4*)(xr + bj * HALF), xb = *(const f32x4*)(xr + bj * HALF + 4);
                    const f32x4 v0 = acc[ai][bj][m][0] + alpha * xa, v1 = acc[ai][bj][m][1] + alpha * xb;
                    u32x4 w; w.x = cvt_pk_bf16(v0[0], v0[1]); w.y = cvt_pk_bf16(v0[2], v0[3]); w.z = cvt_pk_bf16(v1[0], v1[1]); w.w = cvt_pk_bf16(v1[2], v1[3]);
                    *(u32x4*)(H + (size_t)row * 1024 + col0 + bj * HALF) = w; } }
    }
};
}

template <int MODE>
__device__ __forceinline__ void wprep_mat(const Params& p, float* tile, const float* src, const int N, const int ntn, const int njobs, const int bid0, const int nb) {
    const int tid = opaque_tid();
    for (int job = bid0; job < njobs; job += nb) {
        const int kt = job / ntn, nt = job % ntn, k0 = kt * 64, n0 = nt * 64;
        { const int kr = tid >> 4, nc = (tid & 15) * 4;
#pragma unroll
          for (int ps = 0; ps < 2; ++ps) { const int k = k0 + kr + ps * 32, n = n0 + nc; f32x4 v = (f32x4){0.f, 0.f, 0.f, 0.f};
              if (n < N) v = *(const f32x4*)(src + (size_t)k * N + n);
              float* tp = tile + (kr + ps * 32) * 65 + nc; tp[0] = v[0]; tp[1] = v[1]; tp[2] = v[2]; tp[3] = v[3]; } }
        __syncthreads();
        { const int nr = tid >> 3, kc = (tid & 7) * 8, n = n0 + nr;
          if (n < N) { float v[8];
#pragma unroll
              for (int e = 0; e < 8; ++e) v[e] = tile[(kc + e) * 65 + nr];
              u32x4 w; w.x = cvt_pk_bf16(v[0], v[1]); w.y = cvt_pk_bf16(v[2], v[3]); w.z = cvt_pk_bf16(v[4], v[5]); w.w = cvt_pk_bf16(v[6], v[7]);
              size_t doff;
              if (MODE == 0) {
                  if (n < 512) doff = OFF_WMAIN + (size_t)(1536 + n) * 2048;
                  else if (n < 1024) doff = OFF_WMAIN + (size_t)(2048 + n - 512) * 2048;
                  else if (n < 1536) doff = OFF_WV + (size_t)(n - 1024) * 2048;
                  else if (n < 2048) doff = OFF_WMAIN + (size_t)(n - 1536) * 2048;
                  else if (n < 2560) doff = OFF_WMAIN + (size_t)(512 + n - 2048) * 2048;
                  else if (n < 3072) doff = OFF_WMAIN + (size_t)(1024 + n - 2560) * 2048;
                  else if (n < 3584) doff = OFF_WMAIN + (size_t)(2560 + n - 3072) * 2048;
                  else doff = OFF_WG + (size_t)(n - 3584) * 2048;
              } else if (MODE == 1) doff = OFF_WOUT + (size_t)n * 2048;
              else if (MODE == 2) doff = OFF_WUP + (size_t)n * 2048;
              else doff = OFF_WDOWN + (size_t)n * 5632;
              *(u32x4*)(p.ws + doff + (size_t)(k0 + kc) * 2) = w; } }
        __syncthreads();
    }
}
__device__ __forceinline__ void phase_wprep(const Params& p, unsigned char* smem, const int part, const int bid0, const int nb) {
    float* tile = (float*)smem;
    if (part == 0) wprep_mat<0>(p, tile, p.w_in, 3600, 57, 912, bid0, nb);
    else if (part == 1) { wprep_mat<1>(p, tile, p.w_out, 1024, 16, 256, bid0, nb); wprep_mat<3>(p, tile, p.w_down, 1024, 16, 704, bid0, nb); }
    else wprep_mat<2>(p, tile, p.w_up, 5632, 88, 1408, bid0, nb);
}

__device__ __forceinline__ void phase_xconv(const Params& p, unsigned char* smem) {
    bf16_t* wg = (bf16_t*)smem; bf16_t* tile = (bf16_t*)(smem + 33024); float* red = (float*)(smem + 66048);
    const int tid = opaque_tid(), wid = tid >> 6, lane = tid & 63, c = lane & 15, g = lane >> 4;
    for (int idx = tid; idx < 16384; idx += 512) { const int k = idx >> 4, n = idx & 15; wg[n * 1032 + k] = f2bf(p.w_in[(size_t)k * 3600 + 3584 + n]); }
    bf16_t* xb = (bf16_t*)(p.ws + OFF_XB);
    float* gates = (float*)((unsigned char*)p.out + OOFF_GATES);
    const int row = tid >> 5, seg = tid & 31;
    f32x4 cur[8];
    int grp = blockIdx.x;
    if (grp < T_TOK / 16) { const float* src = xrow(p, grp * 16 + row) + 4 * seg;
#pragma unroll
        for (int j = 0; j < 8; ++j) cur[j] = __builtin_nontemporal_load((const f32x4*)(src + 128 * j)); }
    __syncthreads();
    for (; grp < T_TOK / 16; grp += gridDim.x) {
        bf16_t* dst = xb + (size_t)(grp * 16 + row) * 1024 + 4 * seg;
#pragma unroll
        for (int j = 0; j < 8; ++j) { u32x2 w; w.x = cvt_pk_bf16(cur[j][0], cur[j][1]); w.y = cvt_pk_bf16(cur[j][2], cur[j][3]);
            *(u32x2*)(dst + 128 * j) = w; *(u32x2*)(tile + row * 1032 + 128 * j + 4 * seg) = w; }
        const int nxt = grp + gridDim.x;
        if (nxt < T_TOK / 16) { const float* src = xrow(p, nxt * 16 + row) + 4 * seg;
#pragma unroll
            for (int j = 0; j < 8; ++j) cur[j] = __builtin_nontemporal_load((const f32x4*)(src + 128 * j)); }
        __syncthreads();
        { f32x4 acc = (f32x4){0.f, 0.f, 0.f, 0.f};
#pragma unroll
          for (int ks = 0; ks < 4; ++ks) { const bf16x8 af = *(const bf16x8*)(tile + c * 1032 + 128 * wid + 32 * ks + 8 * g), bfr = *(const bf16x8*)(wg + c * 1032 + 128 * wid + 32 * ks + 8 * g);
              acc = __builtin_amdgcn_mfma_f32_16x16x32_bf16(af, bfr, acc, 0, 0, 0); }
#pragma unroll
          for (int i = 0; i < 4; ++i) red[wid * 256 + (4 * g + i) * 16 + c] = acc[i]; }
        __syncthreads();
        if (tid < 256) { float sum = 0.f;
#pragma unroll
            for (int w = 0; w < 8; ++w) sum += red[w * 256 + tid];
            gates[(size_t)grp * 256 + tid] = sum; }
        __syncthreads();
    }
}

__device__ __forceinline__ void phase_na(const Params& p, unsigned char* smem) {
    float* rpbs = (float*)smem;
    const int tid = opaque_tid(), wid = tid >> 6, lane = tid & 63, c = lane & 15, g = lane >> 4;
    for (int i = tid; i < 8 * 15 * 31; i += 512) rpbs[i] = p.rpb[i];
    __syncthreads();
    const bf16_t* QK = (const bf16_t*)(p.ws + OFF_NA2);
    const bf16_t* VT = (const bf16_t*)(p.ws + OFF_VT);
    bf16_t* mix = (bf16_t*)(p.ws + OFF_MIX);
    const bool xcd_order = (gridDim.x == 256);
    const int nsteps = xcd_order ? 12 : (3072 + (int)gridDim.x - 1) / (int)gridDim.x;
    for (int step = 0; step < nsteps; ++step) {
        int plane, rp2;
        if (xcd_order) { const int xcd = blockIdx.x & 7, idx = blockIdx.x >> 3; plane = xcd * 48 + step * 4 + (idx >> 3); rp2 = idx & 7; }
        else { const int sid = step * (int)gridDim.x + (int)blockIdx.x; if (sid >= 3072) break; plane = sid >> 3; rp2 = sid & 7; }
        const int b = plane >> 3, h = plane & 7;
        const int r0 = 2 * (2 * rp2 + (wid >> 2)), cb = wid & 3;
        const int rsA = min(max(r0 - 4, 0), 24), rsB = min(max(r0 - 3, 0), 24), dB = rsB - rsA;
        const int kc0 = min(max(cb * 16 - 8, 0), 32);
        const int qc = cb * 16 + c, tokqA = b * SEQL + r0 * 64 + qc, tokqB = tokqA + 64;
        bf16x8 qA[2], qB[2];
#pragma unroll
        for (int ks = 0; ks < 2; ++ks) {
            qA[ks] = *(const bf16x8*)(QK + (size_t)h * ((size_t)T_TOK * 64) + (size_t)(tokqA >> 3) * 512 + ks * 256 + (tokqA & 7) * 32 + 8 * g);
            qB[ks] = *(const bf16x8*)(QK + (size_t)h * ((size_t)T_TOK * 64) + (size_t)(tokqB >> 3) * 512 + ks * 256 + (tokqB & 7) * 32 + 8 * g); }
        const int th = c + (cb == 0 ? -8 : (cb == 3 ? 8 : 0));
        bool use0[4]; int dcs[4];
#pragma unroll
        for (int i = 0; i < 4; ++i) { use0[i] = (4 * g + i) >= th; const int kc = kc0 + 4 * g + i + (use0[i] ? 0 : 16); dcs[i] = kc - qc + 15; }
        float sA[8][4], tB[9][4];
        {
            const bf16_t* kplane = QK + (size_t)(8 + h) * ((size_t)T_TOK * 64) + (c & 7) * 32 + 8 * g;
            const size_t tok0 = (size_t)b * SEQL + kc0 + c;
#pragma unroll
            for (int jj = 0; jj < 9; ++jj) {
                const int row = min(rsA + jj, 31);
                const bf16_t* kb = kplane + ((tok0 + row * 64) >> 3) * 512;
                bf16x8 kf[2][2];
#pragma unroll
                for (int kt = 0; kt < 2; ++kt)
#pragma unroll
                    for (int ks = 0; ks < 2; ++ks) kf[kt][ks] = *(const bf16x8*)(kb + kt * 2 * 512 + ks * 256);
                f32x4 aA[2], aB[2];
#pragma unroll
                for (int kt = 0; kt < 2; ++kt) {
                    aA[kt] = (f32x4){0.f, 0.f, 0.f, 0.f}; aB[kt] = (f32x4){0.f, 0.f, 0.f, 0.f};
#pragma unroll
                    for (int ks = 0; ks < 2; ++ks) { if (jj < 8) aA[kt] = __builtin_amdgcn_mfma_f32_16x16x32_bf16(kf[kt][ks], qA[ks], aA[kt], 0, 0, 0);
                        aB[kt] = __builtin_amdgcn_mfma_f32_16x16x32_bf16(kf[kt][ks], qB[ks], aB[kt], 0, 0, 0); } }
#pragma unroll
                for (int i = 0; i < 4; ++i) { if (jj < 8) sA[jj][i] = use0[i] ? aA[0][i] : aA[1][i]; tB[jj][i] = use0[i] ? aB[0][i] : aB[1][i]; }
            }
        }
        float sB[8][4];
#pragma unroll
        for (int j = 0; j < 8; ++j) {
            const float* browA = rpbs + (h * 15 + (rsA + j - r0 + 7)) * 31;
            const float* browB = rpbs + (h * 15 + (rsB + j - r0 + 6)) * 31;
#pragma unroll
            for (int i = 0; i < 4; ++i) { sA[j][i] = sA[j][i] * 0.125f + browA[dcs[i]]; sB[j][i] = (dB ? tB[j + 1][i] : tB[j][i]) * 0.125f + browB[dcs[i]]; }
        }
        float mxA = -1e30f, mxB = -1e30f;
#pragma unroll
        for (int j = 0; j < 8; ++j)
#pragma unroll
            for (int i = 0; i < 4; ++i) { mxA = fmaxf(mxA, sA[j][i]); mxB = fmaxf(mxB, sB[j][i]); }
        mxA = fmaxf(mxA, __shfl_xor(mxA, 16)); mxA = fmaxf(mxA, __shfl_xor(mxA, 32));
        mxB = fmaxf(mxB, __shfl_xor(mxB, 16)); mxB = fmaxf(mxB, __shfl_xor(mxB, 32));
        float sumA = 0.f, sumB = 0.f;
        unsigned pA[8][2], pB[8][2];
#pragma unroll
        for (int j = 0; j < 8; ++j) { float eA[4], eB[4];
#pragma unroll
            for (int i = 0; i < 4; ++i) { eA[i] = __expf(sA[j][i] - mxA); sumA += eA[i]; eB[i] = __expf(sB[j][i] - mxB); sumB += eB[i]; }
            pA[j][0] = cvt_pk_bf16(eA[0], eA[1]); pA[j][1] = cvt_pk_bf16(eA[2], eA[3]); pB[j][0] = cvt_pk_bf16(eB[0], eB[1]); pB[j][1] = cvt_pk_bf16(eB[2], eB[3]); }
        sumA += __shfl_xor(sumA, 16); sumA += __shfl_xor(sumA, 32);
        sumB += __shfl_xor(sumB, 16); sumB += __shfl_xor(sumB, 32);
        f32x4 oA[4], oB[4];
#pragma unroll
        for (int mt = 0; mt < 4; ++mt) { oA[mt] = (f32x4){0.f, 0.f, 0.f, 0.f}; oB[mt] = (f32x4){0.f, 0.f, 0.f, 0.f}; }
        {
            const bf16_t* vplane = VT + (size_t)h * ((size_t)T_TOK * 64) + c * 4;
            const size_t tk0 = (size_t)b * SEQL + kc0 + 4 * g;
#pragma unroll
            for (int jj = 0; jj < 9; ++jj) {
                const int row = min(rsA + jj, 31);
                const bf16_t* vb = vplane + ((tk0 + row * 64) >> 2) * 256;
                u32x2 vlo[4], vhi[4];
#pragma unroll
                for (int mt = 0; mt < 4; ++mt) { vlo[mt] = *(const u32x2*)(vb + mt * 64); vhi[mt] = *(const u32x2*)(vb + mt * 64 + 1024); }
                unsigned b01, b23;
                if (jj == 0) { b01 = dB ? 0u : pB[0][0]; b23 = dB ? 0u : pB[0][1]; }
                else if (jj == 8) { b01 = dB ? pB[7][0] : 0u; b23 = dB ? pB[7][1] : 0u; }
                else { b01 = dB ? pB[jj - 1][0] : pB[jj][0]; b23 = dB ? pB[jj - 1][1] : pB[jj][1]; }
                u32x4 pwB;
                pwB.x = (use0[0] ? (b01 & 0xffffu) : 0u) | (use0[1] ? (b01 & 0xffff0000u) : 0u);
                pwB.y = (use0[2] ? (b23 & 0xffffu) : 0u) | (use0[3] ? (b23 & 0xffff0000u) : 0u);
                pwB.z = (use0[0] ? 0u : (b01 & 0xffffu)) | (use0[1] ? 0u : (b01 & 0xffff0000u));
                pwB.w = (use0[2] ? 0u : (b23 & 0xffffu)) | (use0[3] ? 0u : (b23 & 0xffff0000u));
                u32x4 pwA = (u32x4){0u, 0u, 0u, 0u};
                if (jj < 8) { const unsigned a01 = pA[jj][0], a23 = pA[jj][1];
                    pwA.x = (use0[0] ? (a01 & 0xffffu) : 0u) | (use0[1] ? (a01 & 0xffff0000u) : 0u);
                    pwA.y = (use0[2] ? (a23 & 0xffffu) : 0u) | (use0[3] ? (a23 & 0xffff0000u) : 0u);
                    pwA.z = (use0[0] ? 0u : (a01 & 0xffffu)) | (use0[1] ? 0u : (a01 & 0xffff0000u));
                    pwA.w = (use0[2] ? 0u : (a23 & 0xffffu)) | (use0[3] ? 0u : (a23 & 0xffff0000u)); }
#pragma unroll
                for (int mt = 0; mt < 4; ++mt) {
                    u32x4 vw; vw.x = vlo[mt].x; vw.y = vlo[mt].y; vw.z = vhi[mt].x; vw.w = vhi[mt].y;
                    if (jj < 8) oA[mt] = __builtin_amdgcn_mfma_f32_16x16x32_bf16(as_bf16x8(vw), as_bf16x8(pwA), oA[mt], 0, 0, 0);
                    oB[mt] = __builtin_amdgcn_mfma_f32_16x16x32_bf16(as_bf16x8(vw), as_bf16x8(pwB), oB[mt], 0, 0, 0); }
            }
        }
        const float invA = __builtin_amdgcn_rcpf(sumA), invB = __builtin_amdgcn_rcpf(sumB);
#pragma unroll
        for (int mt = 0; mt < 4; ++mt) {
            u32x2 w; w.x = cvt_pk_bf16(oA[mt][0] * invA, oA[mt][1] * invA); w.y = cvt_pk_bf16(oA[mt][2] * invA, oA[mt][3] * invA);
            *(u32x2*)(mix + (size_t)tokqA * 1024 + h * 64 + mt * 16 + 4 * g) = w;
            u32x2 w2; w2.x = cvt_pk_bf16(oB[mt][0] * invB, oB[mt][1] * invB); w2.y = cvt_pk_bf16(oB[mt][2] * invB, oB[mt][3] * invB);
            *(u32x2*)(mix + (size_t)tokqB * 1024 + h * 64 + mt * 16 + 4 * g) = w2; }
    }
}

typedef short bf16x4 __attribute__((ext_vector_type(4)));
__device__ __forceinline__ bf16x4 as_bf16x4(u32x2 v) { union { u32x2 u; bf16x4 b; } c; c.u = v; return c.b; }
__device__ __forceinline__ float sel4(float a0, float a1, float a2, float a3, int k) { return k == 0 ? a0 : (k == 1 ? a1 : (k == 2 ? a2 : a3)); }
constexpr int PL_KS = 0, PL_VS = 17408, PL_QS = 34816, PL_M1 = 52224, PL_M2 = 68864, PL_XT = 34816, PL_LB = 85504, PL_DT = 103936, PL_GC = 112128, PL_BETA = 112640, PL_EGC = 113152, PL_EGL = 113664, PL_BEG = 114176, PL_WS = 114688, PL_TB = 122880;

template <int D>
__device__ __forceinline__ void prep_attn(const int tid, unsigned char* smem, unsigned char* prep, const int bl, const int h, const int n) {
    const float* M1 = (const float*)(smem + PL_M1); const float* M2 = (const float*)(smem + PL_M2);
    bf16_t* Lb = (bf16_t*)(smem + PL_LB) + D * 64 * 72; float* DT = (float*)(smem + PL_DT) + D * 1024;
    const float* gcs = (const float*)(smem + PL_GC) + D * 64; const float* betas = (const float*)(smem + PL_BETA) + D * 64;
    const size_t pidx = ((size_t)(bl * 4 + h) * 2 + D) * 32 + (D ? 31 - n : n);
    unsigned char* pout = prep + pidx * PREP_ITEM;
    const int t = tid & 255, ip = t >> 2, jb = (t & 3) * 16;
    const float gi = gcs[ip], bi = betas[ip]; const int oi = D ? 63 - ip : ip;
    const float* m1r = M1 + oi * 65 + (D ? 63 - jb : jb); const float* m2r = M2 + oi * 65 + (D ? 63 - jb : jb);
    float av[16], lv[16];
#pragma unroll
    for (int jj = 0; jj < 16; ++jj) { const int jp = jb + jj;
        const float dec = (ip >= jp) ? __expf(gi - gcs[jp]) : 0.f;
        lv[jj] = (ip > jp) ? bi * m1r[D ? -jj : jj] * dec : 0.f;
        av[jj] = m2r[D ? -jj : jj] * dec; }
    { u32x4 w0, w1; w0.x = cvt_pk_bf16(lv[0], lv[1]); w0.y = cvt_pk_bf16(lv[2], lv[3]); w0.z = cvt_pk_bf16(lv[4], lv[5]); w0.w = cvt_pk_bf16(lv[6], lv[7]);
      w1.x = cvt_pk_bf16(lv[8], lv[9]); w1.y = cvt_pk_bf16(lv[10], lv[11]); w1.z = cvt_pk_bf16(lv[12], lv[13]); w1.w = cvt_pk_bf16(lv[14], lv[15]);
      *(u32x4*)(Lb + ip * 72 + jb) = w0; *(u32x4*)(Lb + ip * 72 + jb + 8) = w1; }
    if ((ip >> 4) == (jb >> 4)) { float* dt = DT + (ip >> 4) * 256 + (ip & 15);
#pragma unroll
        for (int jj = 0; jj < 16; ++jj) dt[jj * 16] = lv[jj]; }
    bf16_t* arow = (bf16_t*)(pout + PI_ATTN) + ip * 64 + (jb & 32) + ((jb >> 4) & 1) * 4;
#pragma unroll
    for (int gg = 0; gg < 4; ++gg) { u32x2 w; w.x = cvt_pk_bf16(av[4 * gg], av[4 * gg + 1]); w.y = cvt_pk_bf16(av[4 * gg + 2], av[4 * gg + 3]); *(u32x2*)(arow + 8 * gg) = w; }
}
template <int D>
__device__ __forceinline__ void prep_qdk(const int tid, unsigned char* smem, unsigned char* prep, float* cdarr, const int bl, const int h, const int n) {
    const bf16_t* qs = (const bf16_t*)(smem + PL_QS); const bf16_t* ks = (const bf16_t*)(smem + PL_KS);
    const float* gcs = (const float*)(smem + PL_GC) + D * 64;
    const size_t pidx = ((size_t)(bl * 4 + h) * 2 + D) * 32 + (D ? 31 - n : n);
    unsigned char* pout = prep + pidx * PREP_ITEM;
    const float* egc = (const float*)(smem + PL_EGC) + D * 64; const float* egl = (const float*)(smem + PL_EGL) + D * 64;
    const int t = tid & 255;
#pragma unroll
    for (int rep = 0; rep < 4; ++rep) { const int id = t + rep * 256, ip = id >> 4, q = id & 15, kt = q >> 2, gg = q & 3, oi = D ? 63 - ip : ip;
        const float e = egc[ip];
        const u32x2 lo = *(const u32x2*)(qs + oi * 136 + kt * 32 + 4 * gg), hi = *(const u32x2*)(qs + oi * 136 + kt * 32 + 16 + 4 * gg);
        u32x4 w; w.x = cvt_pk_bf16(bflo(lo.x) * e, bfhi(lo.x) * e); w.y = cvt_pk_bf16(bflo(lo.y) * e, bfhi(lo.y) * e);
        w.z = cvt_pk_bf16(bflo(hi.x) * e, bfhi(hi.x) * e); w.w = cvt_pk_bf16(bflo(hi.y) * e, bfhi(hi.y) * e);
        *(u32x4*)((bf16_t*)(pout + PI_QD) + ip * 128 + q * 8) = w; }
#pragma unroll
    for (int rep = 0; rep < 4; ++rep) { const int id = t + rep * 256, dk = id >> 3, q = id & 7, kt = q >> 2, gg = q & 3;
        float v[8];
#pragma unroll
        for (int sidx = 0; sidx < 8; ++sidx) { const int ip = kt * 32 + (sidx >> 2) * 16 + 4 * gg + (sidx & 3), oi = D ? 63 - ip : ip;
            v[sidx] = bf2f(ks[oi * 136 + dk]) * egl[ip]; }
        u32x4 w; w.x = cvt_pk_bf16(v[0], v[1]); w.y = cvt_pk_bf16(v[2], v[3]); w.z = cvt_pk_bf16(v[4], v[5]); w.w = cvt_pk_bf16(v[6], v[7]);
        *(u32x4*)((bf16_t*)(pout + PI_KDT) + dk * 64 + q * 8) = w; }
    if (t == 0) cdarr[pidx] = egc[63];
}
__device__ __forceinline__ void prep_inv(const int t, unsigned char* smem) {
    const int d = t >> 6, blk = (t >> 4) & 3, jj = t & 15;
    const float* DTb = (const float*)(smem + PL_DT) + d * 1024 + blk * 256;
    bf16_t* Tb = (bf16_t*)(smem + PL_TB) + (d * 4 + blk) * 256;
    float y[16];
#pragma unroll
    for (int i = 0; i < 16; ++i) y[i] = (i == jj) ? 1.f : 0.f;
#pragma unroll
    for (int k = 0; k < 15; ++k) { const float yk = y[k];
#pragma unroll
        for (int i4 = (k + 1) / 4; i4 < 4; ++i4) { const f32x4 a = *(const f32x4*)(DTb + k * 16 + i4 * 4);
#pragma unroll
            for (int q = 0; q < 4; ++q) if (i4 * 4 + q > k) y[i4 * 4 + q] -= a[q] * yk; } }
#pragma unroll
    for (int i = 0; i < 16; ++i) Tb[i * 16 + jj] = f2bf(y[i]);
}
template <int D>
__device__ __forceinline__ void prep_solve(const int tid, unsigned char* smem, unsigned char* prep, const int bl, const int h, const int n) {
    const bf16_t* ks = (const bf16_t*)(smem + PL_KS); const bf16_t* vs = (const bf16_t*)(smem + PL_VS);
    const bf16_t* Lb = (const bf16_t*)(smem + PL_LB) + D * 64 * 72; const bf16_t* Tb = (const bf16_t*)(smem + PL_TB) + D * 1024;
    bf16_t* XT = (bf16_t*)(smem + PL_XT) + D * 256 * 48;
    const size_t pidx = ((size_t)(bl * 4 + h) * 2 + D) * 32 + (D ? 31 - n : n);
    unsigned char* pout = prep + pidx * PREP_ITEM;
    const int w4 = (tid >> 6) & 3, lane = tid & 63, c = lane & 15, g = lane >> 4;
    const bool isw = w4 >= 2; const bf16_t* src = (isw ? ks : vs) + ((64 * w4 + c) & 127);
    const float* scl = (const float*)(smem + (isw ? PL_BEG : PL_BETA)) + D * 64;
    bf16_t* wst = (bf16_t*)(smem + PL_WS) + (D * 2 + (w4 & 1)) * 1024;
#pragma unroll 1
    for (int r = 0; r < 4; ++r) {
        f32x4 acc[4];
#pragma unroll
        for (int nt = 0; nt < 4; ++nt) acc[nt] = (f32x4){0.f, 0.f, 0.f, 0.f};
        for (int kk = 0; kk < r; ++kk) {
            const bf16x4 af = as_bf16x4(*(const u32x2*)(Lb + (16 * r + c) * 72 + 16 * kk + 4 * g));
#pragma unroll
            for (int nt = 0; nt < 4; ++nt) { const bf16x4 bfr = as_bf16x4(*(const u32x2*)(XT + (64 * w4 + 16 * nt + c) * 48 + 16 * kk + 4 * g));
                acc[nt] = __builtin_amdgcn_mfma_f32_16x16x16bf16_1k(af, bfr, acc[nt], 0, 0, 0); }
        }
        const f32x4 sc4 = *(const f32x4*)(scl + 16 * r + 4 * g);
        const bf16x4 tf = as_bf16x4(*(const u32x2*)(Tb + r * 256 + c * 16 + 4 * g));
        f32x4 X[4];
#pragma unroll
        for (int nt = 0; nt < 4; ++nt) { float rr[4];
#pragma unroll
            for (int i = 0; i < 4; ++i) { const int tok = 16 * r + 4 * g + i, oi = D ? 63 - tok : tok; rr[i] = bf2f(src[oi * 136 + 16 * nt]) * sc4[i] - acc[nt][i]; }
            u32x2 rb; rb.x = cvt_pk_bf16(rr[0], rr[1]); rb.y = cvt_pk_bf16(rr[2], rr[3]);
            X[nt] = __builtin_amdgcn_mfma_f32_16x16x16bf16_1k(tf, as_bf16x4(rb), (f32x4){0.f, 0.f, 0.f, 0.f}, 0, 0, 0); }
        u32x2 xb[4];
#pragma unroll
        for (int nt = 0; nt < 4; ++nt) { xb[nt].x = cvt_pk_bf16(X[nt][0], X[nt][1]); xb[nt].y = cvt_pk_bf16(X[nt][2], X[nt][3]); }
        if (r < 3) {
#pragma unroll
            for (int nt = 0; nt < 4; ++nt) *(u32x2*)(XT + (64 * w4 + 16 * nt + c) * 48 + 16 * r + 4 * g) = xb[nt]; }
        if (!isw) {
#pragma unroll
            for (int nt = 0; nt < 4; ++nt) *(u32x2*)((bf16_t*)(pout + PI_UT) + (64 * w4 + 16 * nt + c) * 64 + 16 * r + 4 * g) = xb[nt]; }
        else {
#pragma unroll
            for (int nt = 0; nt < 4; ++nt) { const int pc = perm_k(64 * (w4 & 1) + 16 * nt + c) & 63;
                wst[(4 * g + 0) * 64 + pc] = (bf16_t)(xb[nt].x & 0xffffu); wst[(4 * g + 1) * 64 + pc] = (bf16_t)(xb[nt].x >> 16);
                wst[(4 * g + 2) * 64 + pc] = (bf16_t)(xb[nt].y & 0xffffu); wst[(4 * g + 3) * 64 + pc] = (bf16_t)(xb[nt].y >> 16); }
#pragma unroll
            for (int rep = 0; rep < 2; ++rep) { const int q = lane + 64 * rep, row = q >> 3, ch = q & 7;
                const u32x4 v = *(const u32x4*)(wst + row * 64 + ch * 8);
                *(u32x4*)((bf16_t*)(pout + PI_W) + (16 * r + row) * 128 + 64 * (w4 & 1) + ch * 8) = v; }
        }
    }
}

__device__ __forceinline__ void phase_prep(const Params& p, int grp, unsigned char* smem_base) {
    const bf16_t* seg = (const bf16_t*)(p.ws + OFF_SEG);
    const float* gates = (const float*)((const unsigned char*)p.out + OOFF_GATES);
    unsigned char* prep = p.ws + OFF_PREP; float* cdarr = (float*)(p.ws + OFF_CD);
    u32x4 rows_nx[12];
    { const int tid0 = opaque_tid(), it0 = blockIdx.x;
#pragma unroll
      for (int rr = 0; rr < 12; ++rr) rows_nx[rr] = (u32x4){0u, 0u, 0u, 0u};
      if (tid0 < 384 && it0 < 3072) { const int which = tid0 >> 7, tb = (tid0 & 127) >> 4, cgp = tid0 & 15, hn = it0 & 3, nn = (it0 >> 2) & 31, bn = grp * 24 + (it0 >> 7);
#pragma unroll
        for (int rr = 0; rr < 12; ++rr) { const int pos = nn * 64 + tb * 8 - 2 + rr;
            if (pos >= 0 && pos < SEQL) rows_nx[rr] = *(const u32x4*)(seg + which * 512 + ((size_t)bn * SEQL + pos) * 1536 + hn * 128 + cgp * 8); } } }
    for (int it = blockIdx.x; it < 3072; it += gridDim.x) {
        const int h = it & 3, n = (it >> 2) & 31, bl = it >> 7, b = grp * 24 + bl;
        const int tid = opaque_tid();
        const int wid = tid >> 6, lane = tid & 63, c = lane & 15, g = lane >> 4;
        int lofs = 0; asm volatile("" : "+s"(lofs));
        unsigned char* smem = smem_base + lofs;
        bf16_t* qs = (bf16_t*)(smem + PL_QS); bf16_t* ks = (bf16_t*)(smem + PL_KS); bf16_t* vs = (bf16_t*)(smem + PL_VS);
        float* M1 = (float*)(smem + PL_M1); float* M2 = (float*)(smem + PL_M2);
        float* gcs = (float*)(smem + PL_GC); float* betas = (float*)(smem + PL_BETA);
        const size_t tok0 = (size_t)b * SEQL + n * 64;
        if (tid < 384) {
            const int which = tid >> 7, tb = (tid & 127) >> 4, cgp = tid & 15, chan = h * 128 + cgp * 8;
            const bf16_t* sg = seg + which * 512;
            float cw[5][8];
#pragma unroll
            for (int j = 0; j < 5; ++j) { const f32x4 w0 = *(const f32x4*)(p.gconv + j * 1536 + which * 512 + chan), w1 = *(const f32x4*)(p.gconv + j * 1536 + which * 512 + chan + 4);
                cw[j][0] = w0[0]; cw[j][1] = w0[1]; cw[j][2] = w0[2]; cw[j][3] = w0[3]; cw[j][4] = w1[0]; cw[j][5] = w1[1]; cw[j][6] = w1[2]; cw[j][7] = w1[3]; }
            u32x4 rows[12];
#pragma unroll
            for (int rr = 0; rr < 12; ++rr) rows[rr] = rows_nx[rr];
            bf16_t* dst = (which == 0 ? qs : (which == 1 ? ks : vs)) + cgp * 8;
#pragma unroll
            for (int tt = 0; tt < 8; ++tt) {
                float y[8];
#pragma unroll
                for (int e = 0; e < 8; ++e) y[e] = 0.f;
#pragma unroll
                for (int j = 0; j < 5; ++j) { const u32x4 rv = rows[tt + j];
                    y[0] += cw[j][0] * bflo(rv.x); y[1] += cw[j][1] * bfhi(rv.x); y[2] += cw[j][2] * bflo(rv.y); y[3] += cw[j][3] * bfhi(rv.y);
                    y[4] += cw[j][4] * bflo(rv.z); y[5] += cw[j][5] * bfhi(rv.z); y[6] += cw[j][6] * bflo(rv.w); y[7] += cw[j][7] * bfhi(rv.w); }
                float ss = 0.f;
#pragma unroll
                for (int e = 0; e < 8; ++e) { y[e] = silu_f(y[e]); ss += y[e] * y[e]; }
                ss += __shfl_xor(ss, 1); ss += __shfl_xor(ss, 2); ss += __shfl_xor(ss, 4); ss += __shfl_xor(ss, 8);
                const float sc = (which == 0) ? rsqrtf(ss + 1e-6f) * 0.08838834764831845f : ((which == 1) ? rsqrtf(ss + 1e-6f) : 1.f);
                u32x4 w; w.x = cvt_pk_bf16(y[0] * sc, y[1] * sc); w.y = cvt_pk_bf16(y[2] * sc, y[3] * sc); w.z = cvt_pk_bf16(y[4] * sc, y[5] * sc); w.w = cvt_pk_bf16(y[6] * sc, y[7] * sc);
                *(u32x4*)(dst + (tb * 8 + tt) * 136) = w;
            }
            { const int itn = it + gridDim.x;
              if (itn < 3072) { const int hn = itn & 3, nn = (itn >> 2) & 31, bn = grp * 24 + (itn >> 7);
#pragma unroll
                for (int rr = 0; rr < 12; ++rr) { const int pos = nn * 64 + tb * 8 - 2 + rr; rows_nx[rr] = (u32x4){0u, 0u, 0u, 0u};
                    if (pos >= 0 && pos < SEQL) rows_nx[rr] = *(const u32x4*)(seg + which * 512 + ((size_t)bn * SEQL + pos) * 1536 + hn * 128 + cgp * 8); } } }
        } else if (wid >= 6) {
            const int d = wid - 6, li = d ? 63 - lane : lane;
            const float* gr = gates + (tok0 + li) * 16;
            const float bet = sigmoid_f(gr[d * 4 + h]);
            const float a = gr[8 + d * 4 + h] + p.dt_bias[d * 4 + h];
            const float sp = fmaxf(a, 0.f) + log1pf(__expf(-fabsf(a)));
            float gv = -__expf(p.a_log[d * 4 + h]) * sp;
#pragma unroll
            for (int off = 1; off < 64; off <<= 1) { const float t = __shfl_up(gv, off); if (lane >= off) gv += t; }
            gcs[d * 64 + lane] = gv; betas[d * 64 + lane] = bet;
            { const float eg = __expf(gv), gl = __shfl(gv, 63);
              ((float*)(smem + PL_EGC))[d * 64 + lane] = eg; ((float*)(smem + PL_EGL))[d * 64 + lane] = __expf(gl - gv); ((float*)(smem + PL_BEG))[d * 64 + lane] = bet * eg; }
        }
        __syncthreads();
        {
            const int which = wid >> 2, mt = wid & 3; const bf16_t* X = which ? qs : ks; float* M = which ? M2 : M1;
            bf16x8 af[4];
#pragma unroll
            for (int kk = 0; kk < 4; ++kk) af[kk] = *(const bf16x8*)(X + (mt * 16 + c) * 136 + kk * 32 + 8 * g);
#pragma unroll
            for (int nt = 0; nt < 4; ++nt) { f32x4 a = (f32x4){0.f, 0.f, 0.f, 0.f};
#pragma unroll
                for (int kk = 0; kk < 4; ++kk) { const bf16x8 bfr = *(const bf16x8*)(ks + (nt * 16 + c) * 136 + kk * 32 + 8 * g);
                    a = __builtin_amdgcn_mfma_f32_16x16x32_bf16(af[kk], bfr, a, 0, 0, 0); }
#pragma unroll
                for (int i = 0; i < 4; ++i) M[(mt * 16 + 4 * g + i) * 65 + nt * 16 + c] = a[i]; }
        }
        __syncthreads();
        if (tid < 256) prep_attn<0>(tid, smem, prep, bl, h, n); else prep_attn<1>(tid, smem, prep, bl, h, n);
        __syncthreads();
        if (tid < 128) prep_inv(tid, smem);
        if (tid < 256) prep_qdk<0>(tid, smem, prep, cdarr, bl, h, n); else prep_qdk<1>(tid, smem, prep, cdarr, bl, h, n);
        __syncthreads();
        if (tid < 256) prep_solve<0>(tid, smem, prep, bl, h, n); else prep_solve<1>(tid, smem, prep, bl, h, n);
        __syncthreads();
    }
}

constexpr int SL_W = 0, SL_QD = 17408, SL_ATTN = 34816, SL_KDT = 44032;
__device__ __forceinline__ void phase_scan(const Params& p, int grp, unsigned char* smem) {
    const int tid = opaque_tid(), wv = tid >> 6, lane = tid & 63, c = lane & 15, g = lane >> 4;
    const unsigned char* prep = p.ws + OFF_PREP; const float* cdarr = (const float*)(p.ws + OFF_CD);
    bf16_t* O4 = (bf16_t*)((unsigned char*)p.out + OOFF_O);
    (void)grp;
    constexpr int SBUF = 62464;
    for (int it = blockIdx.x; it < 192; it += gridDim.x) {
        const int d = it & 1, h = (it >> 1) & 3, bl = it >> 3;
        const unsigned char* pbase = prep + (size_t)it * 32 * PREP_ITEM; const float* cdp = cdarr + (size_t)it * 32;
        f32x4 S[8];
#pragma unroll
        for (int m = 0; m < 8; ++m) S[m] = (f32x4){0.f, 0.f, 0.f, 0.f};
        u32x4 st[7];
#define SCAN_LOAD(src) do { _Pragma("unroll") for (int k = 0; k < 7; ++k) st[k] = *(const u32x4*)((src) + (size_t)(tid + 512 * k) * 16); } while (0)
#define SCAN_STORE(sb) do { \
        _Pragma("unroll") for (int k = 0; k < 2; ++k) { const int id = tid + 512 * k; *(u32x4*)((sb) + SL_W + (id >> 4) * 272 + (id & 15) * 16) = st[k]; } \
        _Pragma("unroll") for (int k = 2; k < 4; ++k) { const int id = tid + 512 * (k - 2); *(u32x4*)((sb) + SL_QD + (id >> 4) * 272 + (id & 15) * 16) = st[k]; } \
        { const int id = tid; *(u32x4*)((sb) + SL_ATTN + (id >> 3) * 144 + (id & 7) * 16) = st[4]; } \
        _Pragma("unroll") for (int k = 5; k < 7; ++k) { const int id = tid + 512 * (k - 5); *(u32x4*)((sb) + SL_KDT + (id >> 3) * 144 + (id & 7) * 16) = st[k]; } } while (0)
        SCAN_LOAD(pbase); SCAN_STORE(smem);
        SCAN_LOAD(pbase + PREP_ITEM);
        u32x2 uun[4]; float cdn = cdp[0];
#pragma unroll
        for (int mt = 0; mt < 4; ++mt) uun[mt] = *(const u32x2*)(pbase + PI_UT + ((16 * wv + c) * 64 + 16 * mt + 4 * g) * 2);
        __syncthreads();
        for (int n = 0; n < 32; ++n) {
            const unsigned char* cur = pbase + (size_t)n * PREP_ITEM;
            unsigned char* sb = smem + (n & 1) * SBUF;
            if (n < 31) SCAN_STORE(smem + ((n + 1) & 1) * SBUF);
            if (n < 30) SCAN_LOAD(cur + 2 * PREP_ITEM);
            u32x2 uu[4]; const float cdv = cdn;
#pragma unroll
            for (int mt = 0; mt < 4; ++mt) uu[mt] = uun[mt];
            if (n < 31) { cdn = cdp[n + 1];
#pragma unroll
                for (int mt = 0; mt < 4; ++mt) uun[mt] = *(const u32x2*)(cur + PREP_ITEM + PI_UT + ((16 * wv + c) * 64 + 16 * mt + 4 * g) * 2); }
            bf16x8 Sb[4];
#pragma unroll
            for (int kt = 0; kt < 4; ++kt) { u32x4 w; w.x = cvt_pk_bf16(S[2 * kt][0], S[2 * kt][1]); w.y = cvt_pk_bf16(S[2 * kt][2], S[2 * kt][3]);
                w.z = cvt_pk_bf16(S[2 * kt + 1][0], S[2 * kt + 1][1]); w.w = cvt_pk_bf16(S[2 * kt + 1][2], S[2 * kt + 1][3]); Sb[kt] = as_bf16x8(w); }
            f32x4 av[4], ao[4];
#pragma unroll
            for (int mt = 0; mt < 4; ++mt) { f32x4 a = (f32x4){0.f, 0.f, 0.f, 0.f};
#pragma unroll
                for (int kt = 0; kt < 4; ++kt) { const bf16x8 af = *(const bf16x8*)(sb + SL_W + (16 * mt + c) * 272 + (32 * kt + 8 * g) * 2);
                    a = __builtin_amdgcn_mfma_f32_16x16x32_bf16(af, Sb[kt], a, 0, 0, 0); }
                av[mt] = a; }
#pragma unroll
            for (int mt = 0; mt < 4; ++mt) { f32x4 a = (f32x4){0.f, 0.f, 0.f, 0.f};
#pragma unroll
                for (int kt = 0; kt < 4; ++kt) { const bf16x8 af = *(const bf16x8*)(sb + SL_QD + (16 * mt + c) * 272 + (32 * kt + 8 * g) * 2);
                    a = __builtin_amdgcn_mfma_f32_16x16x32_bf16(af, Sb[kt], a, 0, 0, 0); }
                ao[mt] = a; }
            f32x4 v[4];
#pragma unroll
            for (int mt = 0; mt < 4; ++mt) v[mt] = (f32x4){bflo(uu[mt].x) - av[mt][0], bfhi(uu[mt].x) - av[mt][1], bflo(uu[mt].y) - av[mt][2], bfhi(uu[mt].y) - av[mt][3]};
            bf16x8 Vb[2];
#pragma unroll
            for (int kt = 0; kt < 2; ++kt) { u32x4 w; w.x = cvt_pk_bf16(v[2 * kt][0], v[2 * kt][1]); w.y = cvt_pk_bf16(v[2 * kt][2], v[2 * kt][3]);
                w.z = cvt_pk_bf16(v[2 * kt + 1][0], v[2 * kt + 1][1]); w.w = cvt_pk_bf16(v[2 * kt + 1][2], v[2 * kt + 1][3]); Vb[kt] = as_bf16x8(w); }
            const int no = d ? 31 - n : n;
#pragma unroll
            for (int mt = 0; mt < 4; ++mt) { f32x4 a = ao[mt];
#pragma unroll
                for (int kt = 0; kt < 2; ++kt) { const bf16x8 af = *(const bf16x8*)(sb + SL_ATTN + (16 * mt + c) * 144 + (32 * kt + 8 * g) * 2);
                    a = __builtin_amdgcn_mfma_f32_16x16x32_bf16(af, Vb[kt], a, 0, 0, 0); }
                ao[mt] = a; }
#pragma unroll
            for (int m8 = 0; m8 < 8; ++m8) { f32x4 a = S[m8] * cdv;
#pragma unroll
                for (int kt = 0; kt < 2; ++kt) { const bf16x8 af = *(const bf16x8*)(sb + SL_KDT + (16 * m8 + c) * 144 + (32 * kt + 8 * g) * 2);
                    a = __builtin_amdgcn_mfma_f32_16x16x32_bf16(af, Vb[kt], a, 0, 0, 0); }
                S[m8] = a; }
#pragma unroll
            for (int mt = 0; mt < 4; ++mt) {
                const int l0 = d ? 60 - 16 * mt - 4 * g : 16 * mt + 4 * g;
                u32x2 w; if (d) { w.x = cvt_pk_bf16(ao[mt][3], ao[mt][2]); w.y = cvt_pk_bf16(ao[mt][1], ao[mt][0]); }
                else { w.x = cvt_pk_bf16(ao[mt][0], ao[mt][1]); w.y = cvt_pk_bf16(ao[mt][2], ao[mt][3]); }
                *(u32x2*)(O4 + (((size_t)d * 12288 + (((size_t)bl * SEQL + no * 64 + l0) >> 2)) * 512 + h * 128 + 16 * wv + c) * 4) = w; }
            __syncthreads();
        }
#undef SCAN_LOAD
#undef SCAN_STORE
    }
}

__device__ __forceinline__ void phase_combine(const Params& p, int grp) {
    const bf16_t* O4 = (const bf16_t*)((const unsigned char*)p.out + OOFF_O);
    const bf16_t* Z = (const bf16_t*)((const unsigned char*)p.out + OOFF_Z);
    bf16_t* mix = (bf16_t*)(p.ws + OFF_MIX);
    const int total = 12288 * 4 * 32, nthr = gridDim.x * 512;
    const int q = opaque_tid() & 31;
    const f32x4 nwv = *(const f32x4*)(p.gnorm + 4 * q);
    for (int gt = blockIdx.x * 512 + opaque_tid(); gt < total; gt += nthr) {
        const int h = (gt >> 5) & 3, tg4 = gt >> 7;
        const bf16_t* of = O4 + ((size_t)tg4 * 512 + h * 128 + 4 * q) * 4; const bf16_t* ob = of + (size_t)12288 * 512 * 4;
        const u32x4 f0 = __builtin_nontemporal_load((const u32x4*)of), f1 = __builtin_nontemporal_load((const u32x4*)(of + 8)), b0 = __builtin_nontemporal_load((const u32x4*)ob), b1 = __builtin_nontemporal_load((const u32x4*)(ob + 8));
        const size_t tokg = (size_t)grp * 49152 + (size_t)tg4 * 4;
        u32x2 zv[4];
#pragma unroll
        for (int t = 0; t < 4; ++t) zv[t] = *(const u32x2*)(Z + (tokg + t) * 512 + h * 128 + 4 * q);
        const unsigned fw[8] = {f0.x, f0.y, f0.z, f0.w, f1.x, f1.y, f1.z, f1.w}, bw[8] = {b0.x, b0.y, b0.z, b0.w, b1.x, b1.y, b1.z, b1.w};
        float o[4][4];
#pragma unroll
        for (int j = 0; j < 4; ++j) { o[j][0] = bflo(fw[2 * j]) + bflo(bw[2 * j]); o[j][1] = bfhi(fw[2 * j]) + bfhi(bw[2 * j]);
            o[j][2] = bflo(fw[2 * j + 1]) + bflo(bw[2 * j + 1]); o[j][3] = bfhi(fw[2 * j + 1]) + bfhi(bw[2 * j + 1]); }
#pragma unroll
        for (int t = 0; t < 4; ++t) {
            float ss = (o[0][t] * o[0][t] + o[1][t] * o[1][t]) + (o[2][t] * o[2][t] + o[3][t] * o[3][t]);
            ss += __shfl_xor(ss, 1); ss += __shfl_xor(ss, 2); ss += __shfl_xor(ss, 4); ss += __shfl_xor(ss, 8); ss += __shfl_xor(ss, 16);
            const float r = rsqrtf(ss * (1.f / 128.f) + 1e-6f);
            const float z0 = bflo(zv[t].x), z1 = bfhi(zv[t].x), z2 = bflo(zv[t].y), z3 = bfhi(zv[t].y);
            u32x2 w; w.x = cvt_pk_bf16(o[0][t] * r * nwv[0] * silu_f(z0), o[1][t] * r * nwv[1] * silu_f(z1)); w.y = cvt_pk_bf16(o[2][t] * r * nwv[2] * silu_f(z2), o[3][t] * r * nwv[3] * silu_f(z3));
            *(u32x2*)(mix + (tokg + t) * 1024 + 512 + h * 128 + 4 * q) = w; }
    }
}

template <bool OUT_BF16, int IN_BF16>
__device__ __forceinline__ void phase_ln(const void* inp, const void* inp2, const void* inp3, void* outp, const float* gam, const float* bet, const int row_lo, const int row_hi) {
    const int tid = opaque_tid(), wid = tid >> 6, lane = tid & 63;
    f32x4 gv[4], bv[4];
#pragma unroll
    for (int j = 0; j < 4; ++j) { gv[j] = *(const f32x4*)(gam + j * 256 + lane * 4); bv[j] = *(const f32x4*)(bet + j * 256 + lane * 4); }
    for (int row0 = row_lo + (blockIdx.x * 8 + wid) * 4; row0 < row_hi; row0 += gridDim.x * 32) {
        f32x4 v[4][4]; float s[4] = {0.f, 0.f, 0.f, 0.f}, s2[4] = {0.f, 0.f, 0.f, 0.f};
#pragma unroll
        for (int rr = 0; rr < 4; ++rr)
#pragma unroll
            for (int j = 0; j < 4; ++j) {
                if (IN_BF16 == 3) { const int row = row0 + rr; const float* xr = (row < T_PROMPT) ? (const float*)inp + (size_t)row * 1024 : (const float*)inp3 + (size_t)(row - T_PROMPT) * 1024;
                    const f32x4 xv = __builtin_nontemporal_load((const f32x4*)(xr + lane * 4 + j * 256)); const u32x2 fv = __builtin_nontemporal_load((const u32x2*)((const bf16_t*)inp2 + (size_t)row * 1024 + lane * 4 + j * 256));
                    v[rr][j] = (f32x4){DN_ALPHA * xv[0] + bflo(fv.x), DN_ALPHA * xv[1] + bfhi(fv.x), DN_ALPHA * xv[2] + bflo(fv.y), DN_ALPHA * xv[3] + bfhi(fv.y)}; }
                else if (IN_BF16 == 2) { const u32x2 hv = __builtin_nontemporal_load((const u32x2*)((const bf16_t*)inp + (size_t)(row0 + rr) * 1024 + lane * 4 + j * 256)), fv = __builtin_nontemporal_load((const u32x2*)((const bf16_t*)inp2 + (size_t)(row0 + rr) * 1024 + lane * 4 + j * 256));
                    v[rr][j] = (f32x4){DN_ALPHA * bflo(hv.x) + bflo(fv.x), DN_ALPHA * bfhi(hv.x) + bfhi(fv.x), DN_ALPHA * bflo(hv.y) + bflo(fv.y), DN_ALPHA * bfhi(hv.y) + bfhi(fv.y)}; }
                else if (IN_BF16 == 1) { const u32x2 hv = *(const u32x2*)((const bf16_t*)inp + (size_t)(row0 + rr) * 1024 + lane * 4 + j * 256); v[rr][j] = (f32x4){bflo(hv.x), bfhi(hv.x), bflo(hv.y), bfhi(hv.y)}; }
                else v[rr][j] = *(const f32x4*)((const float*)inp + (size_t)(row0 + rr) * 1024 + lane * 4 + j * 256); }
#pragma unroll
        for (int rr = 0; rr < 4; ++rr) {
#pragma unroll
            for (int j = 0; j < 4; ++j) s[rr] += (v[rr][j][0] + v[rr][j][1]) + (v[rr][j][2] + v[rr][j][3]);
#pragma unroll
            for (int o = 1; o < 64; o <<= 1) s[rr] += __shfl_xor(s[rr], o);
            const float mean = s[rr] * (1.f / 1024.f);
#pragma unroll
            for (int j = 0; j < 4; ++j) { v[rr][j] = v[rr][j] - mean; s2[rr] += (v[rr][j][0] * v[rr][j][0] + v[rr][j][1] * v[rr][j][1]) + (v[rr][j][2] * v[rr][j][2] + v[rr][j][3] * v[rr][j][3]); }
#pragma unroll
            for (int o = 1; o < 64; o <<= 1) s2[rr] += __shfl_xor(s2[rr], o);
            const float rstd = rsqrtf(s2[rr] * (1.f / 1024.f) + 1e-5f);
#pragma unroll
            for (int j = 0; j < 4; ++j) { const f32x4 y = v[rr][j] * rstd * gv[j] + bv[j];
                if (OUT_BF16) { u32x2 w; w.x = cvt_pk_bf16(y[0], y[1]); w.y = cvt_pk_bf16(y[2], y[3]); *(u32x2*)((bf16_t*)outp + (size_t)(row0 + rr) * 1024 + j * 256 + lane * 4) = w; }
                else __builtin_nontemporal_store(y, (f32x4*)((float*)outp + (size_t)(row0 + rr) * 1024 + j * 256 + lane * 4)); }
        }
    }
}

__device__ __forceinline__ void phase_ffnact(const Params& p) {
    const bf16_t* hdn = (const bf16_t*)(p.ws + OFF_HDN); bf16_t* act = (bf16_t*)(p.ws + OFF_ACT);
    const int total = 4096 * 352, nthr = gridDim.x * 512;
    for (int idx = blockIdx.x * 512 + opaque_tid(); idx < total; idx += nthr) {
        const int cgp = idx % 352, tblk = idx / 352, c0 = cgp * 8, t0 = tblk * 8, pos0 = t0 & (SEQL - 1);
        const bf16_t* hp = hdn + (size_t)t0 * 5632 + c0;
        const u32x4 zero4 = (u32x4){0u, 0u, 0u, 0u};
        u32x4 gr[10], vr[10];
#pragma unroll
        for (int rr = 0; rr < 10; ++rr) { const int pos = pos0 - 1 + rr; gr[rr] = zero4; vr[rr] = zero4;
            if (pos >= 0 && pos < SEQL) { gr[rr] = __builtin_nontemporal_load((const u32x4*)(hp + (ptrdiff_t)(rr - 1) * 5632)); vr[rr] = __builtin_nontemporal_load((const u32x4*)(hp + (ptrdiff_t)(rr - 1) * 5632 + 2816)); } }
        float wg_[3][8], wv_[3][8], bg[8], bv[8];
#pragma unroll
        for (int j = 0; j < 3; ++j) { const f32x4 a0 = *(const f32x4*)(p.fconvw + j * 5632 + c0), a1 = *(const f32x4*)(p.fconvw + j * 5632 + c0 + 4);
            const f32x4 b0 = *(const f32x4*)(p.fconvw + j * 5632 + 2816 + c0), b1 = *(const f32x4*)(p.fconvw + j * 5632 + 2816 + c0 + 4);
#pragma unroll
            for (int e = 0; e < 4; ++e) { wg_[j][e] = a0[e]; wg_[j][4 + e] = a1[e]; wv_[j][e] = b0[e]; wv_[j][4 + e] = b1[e]; } }
        { const f32x4 a0 = *(const f32x4*)(p.fconvb + c0), a1 = *(const f32x4*)(p.fconvb + c0 + 4), b0 = *(const f32x4*)(p.fconvb + 2816 + c0), b1 = *(const f32x4*)(p.fconvb + 2816 + c0 + 4);
#pragma unroll
          for (int e = 0; e < 4; ++e) { bg[e] = a0[e]; bg[4 + e] = a1[e]; bv[e] = b0[e]; bv[4 + e] = b1[e]; } }
#pragma unroll
        for (int tt = 0; tt < 8; ++tt) {
            const unsigned gpa[4] = {gr[tt].x, gr[tt].y, gr[tt].z, gr[tt].w}, gca[4] = {gr[tt + 1].x, gr[tt + 1].y, gr[tt + 1].z, gr[tt + 1].w}, gna[4] = {gr[tt + 2].x, gr[tt + 2].y, gr[tt + 2].z, gr[tt + 2].w};
            const unsigned vpa[4] = {vr[tt].x, vr[tt].y, vr[tt].z, vr[tt].w}, vca[4] = {vr[tt + 1].x, vr[tt + 1].y, vr[tt + 1].z, vr[tt + 1].w}, vna[4] = {vr[tt + 2].x, vr[tt + 2].y, vr[tt + 2].z, vr[tt + 2].w};
            float y[8];
#pragma unroll
            for (int q = 0; q < 4; ++q) {
                const float G0 = wg_[0][2 * q] * bflo(gpa[q]) + wg_[1][2 * q] * bflo(gca[q]) + wg_[2][2 * q] * bflo(gna[q]) + bg[2 * q];
                const float G1 = wg_[0][2 * q + 1] * bfhi(gpa[q]) + wg_[1][2 * q + 1] * bfhi(gca[q]) + wg_[2][2 * q + 1] * bfhi(gna[q]) + bg[2 * q + 1];
                const float V0 = wv_[0][2 * q] * bflo(vpa[q]) + wv_[1][2 * q] * bflo(vca[q]) + wv_[2][2 * q] * bflo(vna[q]) + bv[2 * q];
                const float V1 = wv_[0][2 * q + 1] * bfhi(vpa[q]) + wv_[1][2 * q + 1] * bfhi(vca[q]) + wv_[2][2 * q + 1] * bfhi(vna[q]) + bv[2 * q + 1];
                y[2 * q] = silu_f(G0) * V0; y[2 * q + 1] = silu_f(G1) * V1; }
            u32x4 w; w.x = cvt_pk_bf16(y[0], y[1]); w.y = cvt_pk_bf16(y[2], y[3]); w.z = cvt_pk_bf16(y[4], y[5]); w.w = cvt_pk_bf16(y[6], y[7]);
            *(u32x4*)(act + (size_t)(t0 + tt) * 2816 + c0) = w;
        }
    }
}

#define XB_TMO      128
#define XB_XCNT(j)  (256  + 64 * (j))
#define XB_XSUB(j)  (1280 + 64 * (j))
#define XB_XGEN(j)  (2304 + 64 * (j))
#define XB_TOP      3328
#define XB_TOPGEN   3392
#define XCD_BAR_WORDS 3456
#define XB_SPIN_CAP (1u << 20)
__device__ __forceinline__ unsigned xb_ld(unsigned* p)              { return __hip_atomic_load(p, __ATOMIC_RELAXED, __HIP_MEMORY_SCOPE_AGENT); }
__device__ __forceinline__ unsigned xb_add(unsigned* p, unsigned v) { return __hip_atomic_fetch_add(p, v, __ATOMIC_RELAXED, __HIP_MEMORY_SCOPE_AGENT); }
__device__ __forceinline__ unsigned xb_xcc_id() { return (unsigned)__builtin_amdgcn_s_getreg((3 << 11) | 20) & 0xFu; }
#define XB_SPIN(cond, bar) do { unsigned _sp = 0; while (cond) { __builtin_amdgcn_s_sleep(1); \
    if ((++_sp & 255u) == 0u) { if (xb_ld(&(bar)[XB_TMO])) break; if (_sp > XB_SPIN_CAP) { atomicAdd(&(bar)[XB_TMO], 1u); break; } } } } while (0)
struct XcdBarrier { unsigned* bar; unsigned x; volatile LAS unsigned* st; };
__device__ __forceinline__ XcdBarrier xcd_barrier_post(unsigned* bar, volatile LAS unsigned* st) {
    XcdBarrier b; b.bar = bar; b.x = xb_xcc_id(); b.st = st;
    if (threadIdx.x == 0) (void)xb_add(&bar[XB_XCNT(b.x)], 1u);
    return b;
}
__device__ __forceinline__ void xcd_barrier_complete(unsigned* bar, unsigned x, unsigned& nloc, unsigned& nx) {
    const unsigned G = gridDim.x * gridDim.y * gridDim.z;
    unsigned sum, cnt, mine, sp = 0u;
    for (;;) {
        sum = 0u; cnt = 0u; mine = 0u;
#pragma unroll
        for (unsigned j = 0; j < 16; ++j) { const unsigned c = xb_ld(&bar[XB_XCNT(j)]); sum += c; cnt += (c > 0u) ? 1u : 0u; mine = (j == x) ? c : mine; }
        if (sum == G) break;
        __builtin_amdgcn_s_sleep(1);
        if ((++sp & 255u) == 0u) { if (xb_ld(&bar[XB_TMO])) break; if (sp > XB_SPIN_CAP) { atomicAdd(&bar[XB_TMO], 1u); break; } }
    }
    nloc = mine > 0u ? mine : 1u; nx = cnt > 0u ? cnt : 1u;
}
__device__ __forceinline__ void xcd_barrier(const XcdBarrier& b) {
    asm volatile("s_waitcnt vmcnt(0)" ::: "memory");
    __syncthreads();
    if (threadIdx.x == 0) {
        unsigned* bar = b.bar;
        __builtin_amdgcn_s_waitcnt(0);
        unsigned nloc = b.st[0], nx = b.st[1];
        if (nloc == 0u) { xcd_barrier_complete(bar, b.x, nloc, nx); b.st[0] = nloc; b.st[1] = nx; }
        const unsigned old = xb_add(&bar[XB_XSUB(b.x)], 1u);
        const unsigned gen = old / nloc;
        if (old + 1u == (gen + 1u) * nloc) {
            __builtin_amdgcn_fence(__ATOMIC_RELEASE, "agent");
            asm volatile("s_waitcnt vmcnt(0)" ::: "memory");
            const unsigned og = xb_add(&bar[XB_TOP], 1u);
            const unsigned tg = og / nx;
            if (og + 1u == (tg + 1u) * nx) xb_add(&bar[XB_TOPGEN], 1u);
            else XB_SPIN(xb_ld(&bar[XB_TOPGEN]) == tg, bar);
            __builtin_amdgcn_fence(__ATOMIC_ACQUIRE, "agent");
            xb_add(&bar[XB_XGEN(b.x)], 1u);
            asm volatile("s_waitcnt vmcnt(0)" ::: "memory");
        } else {
            XB_SPIN(xb_ld(&bar[XB_XGEN(b.x)]) == gen, bar);
            __builtin_amdgcn_fence(__ATOMIC_ACQUIRE, "agent");
            asm volatile("s_waitcnt vmcnt(0)" ::: "memory");
        }
    }
    __syncthreads();
}


__device__ __forceinline__ void ffn_up(const Params& p, const int fg, LAS unsigned char* lds, pg8::StaticOrder& S) {
    pg8::Gemm g{(const bf16_t*)(p.ws + OFF_X1) + (size_t)fg * 32768 * 1024, (const bf16_t*)(p.ws + OFF_WUP), 32768, 5632, 1024};
    pg8::EpiBf16 E{(bf16_t*)(p.ws + OFF_HDN), 5632};
    S.init(g.M, g.N, gridDim.x, blockIdx.x); pg8::gemm_phase(lds, g, S, E);
}
__device__ __forceinline__ void ffn_down(const Params& p, const int fg, LAS unsigned char* lds, pg8::StaticOrder& S) {
    pg8::Gemm g{(const bf16_t*)(p.ws + OFF_ACT), (const bf16_t*)(p.ws + OFF_WDOWN), 32768, 1024, 2816};
    pg8::EpiBf16 E{(bf16_t*)(p.ws + OFF_FFNB) + (size_t)fg * 32768 * 1024, 1024};
    S.init(g.M, g.N, gridDim.x, blockIdx.x); pg8::gemm_phase(lds, g, S, E);
}
#ifndef ONLY
#define ONLY -1
#endif
#define EN(k) (ONLY < 0 || ONLY == (k))
constexpr int N_STEPS = 18;
#ifndef DUP_MASK
#define DUP_MASK 0
#endif
__device__ __forceinline__ void run_step(const Params& p, int step, unsigned char* smem) {
    LAS unsigned char* lds = (LAS unsigned char*)smem;
    pg8::StaticOrder S;
    switch (step) {
    case 0: if (EN(0)) { phase_wprep(p, smem, 0, blockIdx.x, gridDim.x); phase_xconv(p, smem); } break;
    case 1: if (EN(1)) {
        const bf16_t* xb = (const bf16_t*)(p.ws + OFF_XB); const bf16_t* wm = (const bf16_t*)(p.ws + OFF_WMAIN);
        { pg8::Gemm g{xb, wm, T_TOK, 1536, 1024}; pg8::EpiBf16 E{(bf16_t*)(p.ws + OFF_SEG), 1536};
          S.init(g.M, g.N, gridDim.x, blockIdx.x); pg8::gemm_phase(lds, g, S, E); }
        { pg8::Gemm g{xb, wm + (size_t)1536 * 1024, T_TOK, 1024, 1024}; pg8::EpiNAqk E{(bf16_t*)(p.ws + OFF_NA2)};
          S.init(g.M, g.N, gridDim.x, blockIdx.x); pg8::gemm_phase(lds, g, S, E); }
        { pg8::Gemm g{xb, wm + (size_t)2560 * 1024, T_TOK, 512, 1024}; pg8::EpiBf16 E{(bf16_t*)((unsigned char*)p.out + OOFF_Z), 512};
          S.init(g.M, g.N, gridDim.x, blockIdx.x); pg8::gemm_phase(lds, g, S, E); }
        { pg8::Gemm g{(const bf16_t*)(p.ws + OFF_WV), xb, 512, T_TOK, 1024}; pg8::EpiVT E{(bf16_t*)(p.ws + OFF_VT)};
          S.init(g.M, g.N, gridDim.x, blockIdx.x); pg8::gemm_phase(lds, g, S, E); }
    } break;
    case 2: if (EN(2)) phase_na(p, smem); break;
    case 3: if (EN(3)) phase_prep(p, 0, smem); break;
    case 4: if (EN(4)) { phase_scan(p, 0, smem);
              if (gridDim.x > 192) { if (blockIdx.x >= 192) phase_wprep(p, smem, 1, blockIdx.x - 192, gridDim.x - 192); }
              else phase_wprep(p, smem, 1, blockIdx.x, gridDim.x); } break;
    case 5: if (EN(5)) { for (int k = 0; k < 2; ++k) { if ((k == 0) != ((blockIdx.x & 1) != 0)) phase_combine(p, 0); else phase_prep(p, 1, smem); __syncthreads(); } } break;
    case 6: if (EN(4)) { phase_scan(p, 1, smem);
              if (gridDim.x > 192) { if (blockIdx.x >= 192) phase_wprep(p, smem, 2, blockIdx.x - 192, gridDim.x - 192); }
              else phase_wprep(p, smem, 2, blockIdx.x, gridDim.x); } break;
    case 7: if (EN(5)) phase_combine(p, 1); break;
    case 8: if (EN(8)) { pg8::Gemm g{(const bf16_t*)(p.ws + OFF_MIX), (const bf16_t*)(p.ws + OFF_WOUT), T_TOK, 1024, 1024};
              pg8::EpiBf16 E{(bf16_t*)(p.ws + OFF_H1), 1024};
              S.init(g.M, g.N, gridDim.x, blockIdx.x); pg8::gemm_phase(lds, g, S, E); } break;
    case 9: if (EN(9)) phase_ln<true, 3>(p.xp, p.ws + OFF_H1, p.xs, p.ws + OFF_X1, p.ln1g, p.ln1b, 0, T_TOK); break;
    case 10: if (EN(10)) ffn_up(p, 0, lds, S); break;
    case 11: case 13: case 15: if (EN(11)) phase_ffnact(p); break;
    case 12: if (EN(12)) { ffn_down(p, 0, lds, S); ffn_up(p, 1, lds, S); } break;
    case 14: case 16: if (EN(12)) {
              const int fg = (step - 12) / 2;
              for (int k = 0; k < 2; ++k) {
                  if ((k == 0) != ((blockIdx.x & 1) != 0)) phase_ln<false, 2>(p.ws + OFF_X1, p.ws + OFF_FFNB, nullptr, p.out, p.ln2g, p.ln2b, (fg - 1) * 32768, fg * 32768);
                  else { ffn_down(p, fg, lds, S); if (fg < 2) ffn_up(p, fg + 1, lds, S); }
                  __syncthreads(); } } break;
    case 17: if (EN(9)) phase_ln<false, 2>(p.ws + OFF_X1, p.ws + OFF_FFNB, nullptr, p.out, p.ln2g, p.ln2b, 65536, T_TOK); break;
    default: break;
    }
}

template <bool COOP>
__global__ void __launch_bounds__(512, 2) mega(Params p, int s0, int s1) {
    extern __shared__ __attribute__((aligned(16))) unsigned char smem[];
    XcdBarrier xb;
    if (COOP) {
        volatile LAS unsigned* st = (volatile LAS unsigned*)((LAS unsigned char*)smem + LDS_BAR_OFF);
        if (threadIdx.x == 0) { st[0] = 0u; st[1] = 0u; }
        __syncthreads();
        xb = xcd_barrier_post((unsigned*)(p.ws + OFF_BAR), st);
    }
    for (int s = s0; s < s1; ++s) {
        const int nrep = 1 + ((DUP_MASK >> s) & 1);
        for (int rep = 0; rep < nrep; ++rep) {
            int lofs = 0; asm volatile("" : "+s"(lofs));
            run_step(p, s, smem + lofs);
            if (COOP) { if (s + 1 < s1 || rep + 1 < nrep) { if (s0 < 0) cg::this_grid().sync(); else xcd_barrier(xb); } }
            else __syncthreads();
        }
    }
}

extern "C" void kernel_launch(void* const* d_in, const int* in_sizes, int n_in, void* d_out, int out_size, void* d_ws, size_t ws_size, hipStream_t stream) {
    static int grid = 0;
    if (grid == 0) {
        if (n_in != 17 || ws_size < WS_NEED || out_size != T_TOK * 1024) { fprintf(stderr, "kernel_launch: unexpected shapes (n_in %d ws %zu out %d)\n", n_in, ws_size, out_size); grid = -1; return; }
        int dev = 0, cus = 0, per_cu = 0;
        hipGetDevice(&dev); hipDeviceGetAttribute(&cus, hipDeviceAttributeMultiprocessorCount, dev);
        hipFuncSetAttribute((const void*)mega<true>, hipFuncAttributeMaxDynamicSharedMemorySize, LDS_BYTES);
        hipFuncSetAttribute((const void*)mega<false>, hipFuncAttributeMaxDynamicSharedMemorySize, LDS_BYTES);
        hipOccupancyMaxActiveBlocksPerMultiprocessor(&per_cu, (const void*)mega<true>, 512, LDS_BYTES);
        if (per_cu < 1) { fprintf(stderr, "kernel_launch: occupancy query says %d blocks/CU\n", per_cu); per_cu = 1; }
        (void)hipGetLastError();
        grid = cus;
    }
    if (grid < 0) return;
    Params p{};
    p.xp = (const float*)d_in[0]; p.xs = (const float*)d_in[1]; p.w_in = (const float*)d_in[2]; p.rpb = (const float*)d_in[3]; p.gconv = (const float*)d_in[4];
    p.a_log = (const float*)d_in[5]; p.dt_bias = (const float*)d_in[6]; p.gnorm = (const float*)d_in[7]; p.w_out = (const float*)d_in[8]; p.ln1g = (const float*)d_in[9];
    p.ln1b = (const float*)d_in[10]; p.w_up = (const float*)d_in[11]; p.fconvw = (const float*)d_in[12]; p.fconvb = (const float*)d_in[13]; p.w_down = (const float*)d_in[14];
    p.ln2g = (const float*)d_in[15]; p.ln2b = (const float*)d_in[16]; p.out = (float*)d_out; p.ws = (unsigned char*)d_ws;
#if ONE_LAUNCH
    if (hipMemsetAsync((unsigned char*)d_ws + OFF_BAR, 0, XCD_BAR_WORDS * sizeof(unsigned), stream) != hipSuccess) { fprintf(stderr, "kernel_launch: memset of barrier words failed\n"); return; }
    int s0 = 0, s1 = N_STEPS;
    void* args[] = {&p, &s0, &s1};
    hipError_t e = hipLaunchCooperativeKernel((const void*)mega<true>, dim3(grid), dim3(512), args, LDS_BYTES, stream);
    if (e != hipSuccess) fprintf(stderr, "cooperative launch failed: %s (grid %d)\n", hipGetErrorString(e), grid);
#else
    for (int s = 0; s < N_STEPS; ++s) hipLaunchKernelGGL(mega<false>, dim3(grid), dim3(512), LDS_BYTES, stream, p, s, s + 1);
#endif
}
```

```cpp
#include <hip/hip_runtime.h>
#include <hip/hip_cooperative_groups.h>
#include <cstdio>
namespace cg = cooperative_groups;

#define LAS __attribute__((address_space(3)))
typedef unsigned short bf16_t;
typedef short bf16x8 __attribute__((ext_vector_type(8)));
typedef float f32x4 __attribute__((ext_vector_type(4)));
typedef unsigned u32x4 __attribute__((ext_vector_type(4)));
typedef unsigned u32x2 __attribute__((ext_vector_type(2)));

#ifndef ONE_LAUNCH
#define ONE_LAUNCH 1
#endif

constexpr int T_TOK = 98304, T_PROMPT = 32768, SEQL = 2048;
constexpr size_t MiB = (size_t)1 << 20;
constexpr size_t OFF_WMAIN = 0, OFF_WV = 6 * MiB, OFF_WG = 7 * MiB, OFF_WOUT = 8 * MiB, OFF_WUP = 10 * MiB, OFF_WDOWN = 21 * MiB, OFF_CD = 27 * MiB,
                 OFF_XB = 28 * MiB, OFF_MIX = 28 * MiB, OFF_SEG = 220 * MiB, OFF_NA2 = 508 * MiB, OFF_VT = 700 * MiB, OFF_PREP = 508 * MiB, OFF_H1 = 220 * MiB,
                 OFF_X1 = 604 * MiB, OFF_FFNB = 796 * MiB, OFF_HDN = 28 * MiB, OFF_ACT = 380 * MiB, WS_NEED = 1024 * MiB;
constexpr size_t SEG_ELEMS = (size_t)T_TOK * 512;
constexpr size_t OOFF_O = 0, OOFF_GATES = 192 * MiB, OOFF_Z = 198 * MiB;
constexpr int PREP_ITEM = 73728;
constexpr int PI_W = 0, PI_QD = 16384, PI_ATTN = 32768, PI_KDT = 40960, PI_UT = 57344;
constexpr int LDS_BAR_OFF = 155648, LDS_BYTES = LDS_BAR_OFF + 16;
constexpr size_t OFF_BAR = 27 * MiB + 512 * 1024;
constexpr float DN_ALPHA = 1.189207115002721f;

struct Params {
    const float* xp; const float* xs; const float* w_in; const float* rpb; const float* gconv; const float* a_log; const float* dt_bias; const float* gnorm;
    const float* w_out; const float* ln1g; const float* ln1b; const float* w_up; const float* fconvw; const float* fconvb; const float* w_down;
    const float* ln2g; const float* ln2b; float* out; unsigned char* ws;
};

__device__ __forceinline__ int opaque_tid() { int t = threadIdx.x; asm volatile("" : "+v"(t)); return t; }
typedef float f32x2_t __attribute__((ext_vector_type(2)));
typedef __bf16 bf16x2_t __attribute__((ext_vector_type(2)));
__device__ __forceinline__ unsigned cvt_pk_bf16(float lo, float hi) { const f32x2_t v = {lo, hi}; union { bf16x2_t b; unsigned u; } c; c.b = __builtin_convertvector(v, bf16x2_t); return c.u; }
__device__ __forceinline__ float bflo(unsigned u) { return __uint_as_float(u << 16); }
__device__ __forceinline__ float bfhi(unsigned u) { return __uint_as_float(u & 0xffff0000u); }
__device__ __forceinline__ float bf2f(bf16_t b) { return __uint_as_float(((unsigned)b) << 16); }
__device__ __forceinline__ bf16_t f2bf(float f) { return (bf16_t)(cvt_pk_bf16(f, 0.f) & 0xffffu); }
__device__ __forceinline__ float silu_f(float x) { return x * __builtin_amdgcn_rcpf(1.f + __expf(-x)); }
__device__ __forceinline__ float sigmoid_f(float x) { return __builtin_amdgcn_rcpf(1.f + __expf(-x)); }
__device__ __forceinline__ const float* xrow(const Params& p, int row) { return row < T_PROMPT ? p.xp + (size_t)row * 1024 : p.xs + (size_t)(row - T_PROMPT) * 1024; }
__device__ __forceinline__ bf16x8 as_bf16x8(u32x4 v) { union { u32x4 u; bf16x8 b; } c; c.u = v; return c.b; }
__device__ __forceinline__ int perm_k(int c) { return (c & ~31) | (((c >> 2) & 3) << 3) | (((c >> 4) & 1) << 2) | (c & 3); }

namespace pg8 {
constexpr int BM = 256, BK = 64, HALF = 128, HTB = HALF * BK * 2, STAGE_BYTES = 8 * HTB, NXCD = 8, WGM = 8;
__host__ __device__ __forceinline__ int lds_byte(int r, int c) { const int st = (r >> 4) * 2 + (c >> 5), rr = r & 15, cc = c & 31, ob = rr * 64 + cc * 2; return st * 1024 + (ob ^ (((ob >> 9) & 1) << 5)); }
__host__ __device__ __forceinline__ void stage_rc(int b, int& R, int& C) { const int st = b / 1024, sb = b % 1024, swz = sb ^ (((sb >> 9) & 1) << 5); R = (st >> 1) * 16 + swz / 64; C = (st & 1) * 32 + (swz % 64) / 2; }
__host__ __device__ __forceinline__ int perm32(int rho) { const int n = rho >> 4, i = rho & 15; return 8 * (i >> 2) + 4 * n + (i & 3); }
struct Unit { int pm, pn; };
struct Gemm { const bf16_t* A; const bf16_t* Bt; int M, N, K; };
struct StaticOrder {
    int nM, nN, nwg, G, c;
    __device__ void init(int M, int N, int G_, int c_) { nM = M / BM; nN = N / BM; nwg = nM * nN; G = G_; c = c_; }
    __device__ bool next(int i, Unit& u) const {
        const long L = (long)i * G + c; if (L >= nwg) return false;
        int wgid = (int)L; { const int q = nwg / NXCD, r = nwg % NXCD, xcd = wgid % NXCD, off = wgid / NXCD; wgid = (xcd < r ? xcd * (q + 1) : r * (q + 1) + (xcd - r) * q) + off; }
        const int nig = WGM * nN, gid = wgid / nig, fm = gid * WGM, gsz = (nM - fm) < WGM ? (nM - fm) : WGM;
        u.pm = fm + ((wgid % nig) % gsz); u.pn = (wgid % nig) / gsz; return true;
    }
};

template <class Epi>
__device__ __forceinline__ void gemm_phase(LAS unsigned char* lds, const Gemm g, const StaticOrder& S, const Epi& E) {
    const int tid = opaque_tid(), wid = __builtin_amdgcn_readfirstlane(tid >> 6), lane = tid & 63, wr = wid >> 2, wc = wid & 3, fr = lane & 15, fq = lane >> 4;
    const int K = g.K, nt = K / BK;
    unsigned voffA[2], voffB[2];
#pragma unroll
    for (int i = 0; i < 2; ++i) { int R, C; stage_rc(tid * 16 + i * 8192, R, C); const int Rb = Epi::PERM ? ((R & ~31) + perm32(R & 31)) : R;
        voffA[i] = (unsigned)(R * K + C) * 2u; voffB[i] = (unsigned)(Rb * K + C) * 2u; }
    const size_t kstep = (size_t)(BK * 2);
    const size_t hstep = (size_t)HALF * K * 2;
    const size_t tstep = 2 * hstep;
    const unsigned ldsw = (unsigned)wid * 1024u;
    const int aoff = lds_byte(wr * 64 + fr, fq * 8), boff = lds_byte(wc * 32 + fr, fq * 8);
#define PG8_SA(b, h) (((b) * 2 + (h)) * HTB)
#define PG8_SB(b, h) ((4 + (b) * 2 + (h)) * HTB)
#define PG8_STAGE(bufoff, gbase, voff) do { _Pragma("unroll") for (int _i = 0; _i < 2; ++_i) \
        __builtin_amdgcn_global_load_lds((const unsigned*)((const char*)(gbase) + (voff)[_i]), (LAS unsigned*)(lds + (bufoff) + ldsw + _i * 8192), 16, 0, 0); } while (0)
#define PG8_LDA(dst, b, h) do { _Pragma("unroll") for (int m = 0; m < 4; ++m) _Pragma("unroll") for (int k = 0; k < 2; ++k) dst[m][k] = *(const LAS bf16x8*)(lds + PG8_SA(b, h) + aoff + m * 2048 + k * 1024); } while (0)
#define PG8_LDB(dst, b, h) do { _Pragma("unroll") for (int n = 0; n < 2; ++n) _Pragma("unroll") for (int k = 0; k < 2; ++k) dst[n][k] = *(const LAS bf16x8*)(lds + PG8_SB(b, h) + boff + n * 2048 + k * 1024); } while (0)
#define PG8_MMA(ai, bj, At, Bt) do { __builtin_amdgcn_s_setprio(1); _Pragma("unroll") for (int m = 0; m < 4; ++m) _Pragma("unroll") for (int n = 0; n < 2; ++n) _Pragma("unroll") for (int k = 0; k < 2; ++k) \
        acc[ai][bj][m][n] = __builtin_amdgcn_mfma_f32_16x16x32_bf16(Bt[n][k], At[m][k], acc[ai][bj][m][n], 0, 0, 0); __builtin_amdgcn_s_setprio(0); } while (0)
#define PG8_WAIT_V(n) asm volatile("s_waitcnt vmcnt(" #n ")" ::: "memory")
#define PG8_WAIT_L(n) asm volatile("s_waitcnt lgkmcnt(" #n ")" ::: "memory")
#define PG8_BAR __builtin_amdgcn_s_barrier()
#define PG8_SCHED __builtin_amdgcn_sched_barrier(0)
    Unit cur, nxt; int ui = 0;
    if (!S.next(0, cur)) return;
    f32x4 acc[2][2][4][2];
#pragma unroll
    for (int a = 0; a < 2; ++a)
#pragma unroll
        for (int b = 0; b < 2; ++b)
#pragma unroll
            for (int m = 0; m < 4; ++m)
#pragma unroll
                for (int n = 0; n < 2; ++n) acc[a][b][m][n] = (f32x4){0.f, 0.f, 0.f, 0.f};
    bf16x8 At[4][2], B0[2][2], B1[2][2];
    const char* cA = (const char*)g.A + (size_t)cur.pm * tstep; const char* cB = (const char*)g.Bt + (size_t)cur.pn * tstep;
    PG8_STAGE(PG8_SB(0, 0), cB, voffB); PG8_STAGE(PG8_SA(0, 0), cA, voffA); PG8_STAGE(PG8_SB(0, 1), cB + hstep, voffB); PG8_STAGE(PG8_SA(0, 1), cA + hstep, voffA);
    if (wr == 1) PG8_BAR;
    PG8_WAIT_V(4); PG8_BAR;
    PG8_STAGE(PG8_SB(1, 0), cB + kstep, voffB); PG8_STAGE(PG8_SA(1, 0), cA + kstep, voffA); PG8_STAGE(PG8_SB(1, 1), cB + hstep + kstep, voffB);
    PG8_WAIT_V(6); PG8_BAR;
    for (;;) {
        const bool has_next = S.next(ui + 1, nxt);
        const char* nA = has_next ? (const char*)g.A + (size_t)nxt.pm * tstep : cA; const char* nB = has_next ? (const char*)g.Bt + (size_t)nxt.pn * tstep : cB;
        for (int t = 0; t < nt; t += 2) {
            const bool last = (t == nt - 2);
            const char* a1 = cA + (size_t)(t + 1) * kstep;
            const char* a2 = last ? nA : cA + (size_t)(t + 2) * kstep; const char* b2 = last ? nB : cB + (size_t)(t + 2) * kstep;
            const char* a3 = a2 + kstep; const char* b3 = b2 + kstep;
            PG8_LDB(B0, 0, 0); PG8_SCHED; PG8_LDA(At, 0, 0); PG8_STAGE(PG8_SA(1, 1), a1 + hstep, voffA);
            PG8_WAIT_L(8); PG8_BAR; PG8_WAIT_L(0); PG8_MMA(0, 0, At, B0); PG8_BAR; PG8_SCHED;
            PG8_LDB(B1, 0, 1); PG8_STAGE(PG8_SB(0, 0), b2, voffB);
            PG8_BAR; PG8_WAIT_L(0); PG8_MMA(0, 1, At, B1); PG8_BAR;
            PG8_LDA(At, 0, 1); PG8_STAGE(PG8_SA(0, 0), a2, voffA);
            PG8_BAR; PG8_WAIT_L(0); PG8_MMA(1, 0, At, B0); PG8_BAR; PG8_SCHED;
            PG8_STAGE(PG8_SB(0, 1), b2 + hstep, voffB);
            PG8_WAIT_V(6); PG8_BAR; PG8_MMA(1, 1, At, B1); PG8_BAR;
            PG8_LDB(B0, 1, 0); PG8_SCHED; PG8_LDA(At, 1, 0); PG8_STAGE(PG8_SA(0, 1), a2 + hstep, voffA);
            PG8_WAIT_L(8); PG8_BAR; PG8_WAIT_L(0); PG8_MMA(0, 0, At, B0); PG8_BAR; PG8_SCHED;
            PG8_LDB(B1, 1, 1); PG8_STAGE(PG8_SB(1, 0), b3, voffB);
            PG8_BAR; PG8_WAIT_L(0); PG8_MMA(0, 1, At, B1); PG8_BAR;
            PG8_LDA(At, 1, 1); PG8_STAGE(PG8_SA(1, 0), a3, voffA);
            PG8_BAR; PG8_WAIT_L(0); PG8_MMA(1, 0, At, B0); PG8_BAR; PG8_SCHED;
            PG8_STAGE(PG8_SB(1, 1), b3 + hstep, voffB);
            PG8_WAIT_V(6); PG8_BAR; PG8_MMA(1, 1, At, B1); PG8_BAR;
        }
        E(acc, cur, wr, wc, fr, fq);
        if (!has_next) break;
#pragma unroll
        for (int a = 0; a < 2; ++a)
#pragma unroll
            for (int b = 0; b < 2; ++b)
#pragma unroll
                for (int m = 0; m < 4; ++m)
#pragma unroll
                    for (int n = 0; n < 2; ++n) acc[a][b][m][n] = (f32x4){0.f, 0.f, 0.f, 0.f};
        cur = nxt; cA = nA; cB = nB; ++ui;
    }
    PG8_WAIT_V(0);
    if (wr == 0) PG8_BAR;
    PG8_BAR;
#undef PG8_SA
#undef PG8_SB
#undef PG8_STAGE
#undef PG8_LDA
#undef PG8_LDB
#undef PG8_MMA
#undef PG8_WAIT_V
#undef PG8_WAIT_L
#undef PG8_BAR
#undef PG8_SCHED
}

struct EpiBf16 {
    static constexpr bool PERM = true;
    bf16_t* O; int ldc;
    __device__ __forceinline__ void operator()(const f32x4 (&acc)[2][2][4][2], const Unit& u, int wr, int wc, int fr, int fq) const {
        const int row0 = u.pm * BM + wr * 64 + fr, col0 = u.pn * BM + wc * 32 + 8 * fq; bf16_t* base = O;
#pragma unroll
        for (int ai = 0; ai < 2; ++ai)
#pragma unroll
            for (int m = 0; m < 4; ++m) { bf16_t* rowp = base + (size_t)(row0 + ai * HALF + m * 16) * ldc + col0;
#pragma unroll
                for (int bj = 0; bj < 2; ++bj) { const f32x4 v0 = acc[ai][bj][m][0], v1 = acc[ai][bj][m][1];
                    u32x4 w; w.x = cvt_pk_bf16(v0[0], v0[1]); w.y = cvt_pk_bf16(v0[2], v0[3]); w.z = cvt_pk_bf16(v1[0], v1[1]); w.w = cvt_pk_bf16(v1[2], v1[3]);
                    *(u32x4*)(rowp + bj * HALF) = w; } }
    }
};
struct EpiNAqk {
    static constexpr bool PERM = true;
    bf16_t* O;
    __device__ __forceinline__ void operator()(const f32x4 (&acc)[2][2][4][2], const Unit& u, int wr, int wc, int fr, int fq) const {
        const int row0 = u.pm * BM + wr * 64 + fr;
#pragma unroll
        for (int ai = 0; ai < 2; ++ai)
#pragma unroll
            for (int m = 0; m < 4; ++m) { const int tok = row0 + ai * HALF + m * 16;
#pragma unroll
                for (int bj = 0; bj < 2; ++bj) { const int hh = u.pn * 4 + bj * 2 + (wc >> 1);
                    bf16_t* dst = O + (size_t)hh * ((size_t)T_TOK * 64) + (size_t)(tok >> 3) * 512 + (wc & 1) * 256 + (tok & 7) * 32 + fq * 8;
                    const f32x4 v0 = acc[ai][bj][m][0], v1 = acc[ai][bj][m][1];
                    u32x4 w; w.x = cvt_pk_bf16(v0[0], v0[1]); w.y = cvt_pk_bf16(v0[2], v0[3]); w.z = cvt_pk_bf16(v1[0], v1[1]); w.w = cvt_pk_bf16(v1[2], v1[3]);
                    *(u32x4*)dst = w; } }
    }
};
struct EpiVT {
    static constexpr bool PERM = true;
    bf16_t* O;
    __device__ __forceinline__ void operator()(const f32x4 (&acc)[2][2][4][2], const Unit& u, int wr, int wc, int fr, int fq) const {
        const int row0 = u.pm * BM + wr * 64 + fr, col0 = u.pn * BM + wc * 32 + 8 * fq;
#pragma unroll
        for (int ai = 0; ai < 2; ++ai)
#pragma unroll
            for (int m = 0; m < 4; ++m) { const int f = row0 + ai * HALF + m * 16;
                bf16_t* fb = O + (size_t)(f >> 6) * ((size_t)T_TOK * 64) + (f & 63) * 4;
#pragma unroll
                for (int bj = 0; bj < 2; ++bj)
#pragma unroll
                    for (int n = 0; n < 2; ++n) { const f32x4 v = acc[ai][bj][m][n];
                        u32x2 w; w.x = cvt_pk_bf16(v[0], v[1]); w.y = cvt_pk_bf16(v[2], v[3]);
                        *(u32x2*)(fb + (size_t)(((col0 + bj * HALF) >> 2) + n) * 256) = w; } }
    }
};
template <bool RES_BF16> struct EpiRes {
    static constexpr bool PERM = false;
    float* C; const void* res0; const void* res1; int split_row; float alpha;
    __device__ __forceinline__ void operator()(const f32x4 (&acc)[2][2][4][2], const Unit& u, int wr, int wc, int fr, int fq) const {
        const int row0 = u.pm * BM + wr * 64 + fr, col0 = u.pn * BM + wc * 32 + 4 * fq;
#pragma unroll
        for (int ai = 0; ai < 2; ++ai)
#pragma unroll
            for (int m = 0; m < 4; ++m) { const int row = row0 + ai * HALF + m * 16; float* rowp = C + (size_t)row * 1024 + col0;
                const size_t roff = (row < split_row) ? (size_t)row * 1024 : (size_t)(row - split_row) * 1024; const void* rb = (row < split_row) ? res0 : res1;
#pragma unroll
                for (int bj = 0; bj < 2; ++bj)
#pragma unroll
                    for (int n = 0; n < 2; ++n) { const int co = bj * HALF + n * 16; f32x4 r;
                        if (RES_BF16) { const u32x2 rv = *(const u32x2*)((const bf16_t*)rb + roff + col0 + co); r = (f32x4){bflo(rv.x), bfhi(rv.x), bflo(rv.y), bfhi(rv.y)}; }
                        else r = *(const f32x4*)((const float*)rb + roff + col0 + co);
                        *(f32x4*)(rowp + co) = acc[ai][bj][m][n] + alpha * r; } }
    }
};
struct EpiResToBf16 {
    static constexpr bool PERM = true;
    bf16_t* H; const float* x0; const float* x1; int split_row; float alpha;
    __device__ __forceinline__ void operator()(const f32x4 (&acc)[2][2][4][2], const Unit& u, int wr, int wc, int fr, int fq) const {
        const int row0 = u.pm * BM + wr * 64 + fr, col0 = u.pn * BM + wc * 32 + 8 * fq;
#pragma unroll
        for (int ai = 0; ai < 2; ++ai)
#pragma unroll
            for (int m = 0; m < 4; ++m) { const int row = row0 + ai * HALF + m * 16;
                const float* xr = ((row < split_row) ? x0 + (size_t)row * 1024 : x1 + (size_t)(row - split_row) * 1024) + col0;
#pragma unroll
                for (int bj = 0; bj < 2; ++bj) { const f32x4 xa = *(const f32x4*)(xr + bj * HALF), xb = *(const f32x4*)(xr + bj * HALF + 4);
                    const f32x4 v0 = acc[ai][bj][m][0] + alpha * xa, v1 = acc[ai][bj][m][1] + alpha * xb;
                    u32x4 w; w.x = cvt_pk_bf16(v0[0], v0[1]); w.y = cvt_pk_bf16(v0[2], v0[3]); w.z = cvt_pk_bf16(v1[0], v1[1]); w.w = cvt_pk_bf16(v1[2], v1[3]);
                    *(u32x4*)(H + (size_t)row * 1024 + col0 + bj * HALF) = w; } }
    }
};
}

template <int MODE>
__device__ __forceinline__ void wprep_mat(const Params& p, float* tile, const float* src, const int N, const int ntn, const int njobs, const int bid0, const int nb) {
    const int tid = opaque_tid();
    for (int job = bid0; job < njobs; job += nb) {
        const int kt = job / ntn, nt = job % ntn, k0 = kt * 64, n0 = nt * 64;
        { const int kr = tid >> 4, nc = (tid & 15) * 4;
#pragma unroll
          for (int ps = 0; ps < 2; ++ps) { const int k = k0 + kr + ps * 32, n = n0 + nc; f32x4 v = (f32x4){0.f, 0.f, 0.f, 0.f};
              if (n < N) v = *(const f32x4*)(src + (size_t)k * N + n);
              float* tp = tile + (kr + ps * 32) * 65 + nc; tp[0] = v[0]; tp[1] = v[1]; tp[2] = v[2]; tp[3] = v[3]; } }
        __syncthreads();
        { const int nr = tid >> 3, kc = (tid & 7) * 8, n = n0 + nr;
          if (n < N) { float v[8];
#pragma unroll
              for (int e = 0; e < 8; ++e) v[e] = tile[(kc + e) * 65 + nr];
              u32x4 w; w.x = cvt_pk_bf16(v[0], v[1]); w.y = cvt_pk_bf16(v[2], v[3]); w.z = cvt_pk_bf16(v[4], v[5]); w.w = cvt_pk_bf16(v[6], v[7]);
              size_t doff;
              if (MODE == 0) {
                  if (n < 512) doff = OFF_WMAIN + (size_t)(1536 + n) * 2048;
                  else if (n < 1024) doff = OFF_WMAIN + (size_t)(2048 + n - 512) * 2048;
                  else if (n < 1536) doff = OFF_WV + (size_t)(n - 1024) * 2048;
                  else if (n < 2048) doff = OFF_WMAIN + (size_t)(n - 1536) * 2048;
                  else if (n < 2560) doff = OFF_WMAIN + (size_t)(512 + n - 2048) * 2048;
                  else if (n < 3072) doff = OFF_WMAIN + (size_t)(1024 + n - 2560) * 2048;
                  else if (n < 3584) doff = OFF_WMAIN + (size_t)(2560 + n - 3072) * 2048;
                  else doff = OFF_WG + (size_t)(n - 3584) * 2048;
              } else if (MODE == 1) doff = OFF_WOUT + (size_t)n * 2048;
              else if (MODE == 2) doff = OFF_WUP + (size_t)n * 2048;
              else doff = OFF_WDOWN + (size_t)n * 5632;
              *(u32x4*)(p.ws + doff + (size_t)(k0 + kc) * 2) = w; } }
        __syncthreads();
    }
}
__device__ __forceinline__ void phase_wprep(const Params& p, unsigned char* smem, const int part, const int bid0, const int nb) {
    float* tile = (float*)smem;
    if (part == 0) wprep_mat<0>(p, tile, p.w_in, 3600, 57, 912, bid0, nb);
    else if (part == 1) { wprep_mat<1>(p, tile, p.w_out, 1024, 16, 256, bid0, nb); wprep_mat<3>(p, tile, p.w_down, 1024, 16, 704, bid0, nb); }
    else wprep_mat<2>(p, tile, p.w_up, 5632, 88, 1408, bid0, nb);
}

__device__ __forceinline__ void phase_xconv(const Params& p, unsigned char* smem) {
    bf16_t* wg = (bf16_t*)smem; bf16_t* tile = (bf16_t*)(smem + 33024); float* red = (float*)(smem + 66048);
    const int tid = opaque_tid(), wid = tid >> 6, lane = tid & 63, c = lane & 15, g = lane >> 4;
    for (int idx = tid; idx < 16384; idx += 512) { const int k = idx >> 4, n = idx & 15; wg[n * 1032 + k] = f2bf(p.w_in[(size_t)k * 3600 + 3584 + n]); }
    bf16_t* xb = (bf16_t*)(p.ws + OFF_XB);
    float* gates = (float*)((unsigned char*)p.out + OOFF_GATES);
    const int row = tid >> 5, seg = tid & 31;
    f32x4 cur[8];
    int grp = blockIdx.x;
    if (grp < T_TOK / 16) { const float* src = xrow(p, grp * 16 + row) + 4 * seg;
#pragma unroll
        for (int j = 0; j < 8; ++j) cur[j] = __builtin_nontemporal_load((const f32x4*)(src + 128 * j)); }
    __syncthreads();
    for (; grp < T_TOK / 16; grp += gridDim.x) {
        bf16_t* dst = xb + (size_t)(grp * 16 + row) * 1024 + 4 * seg;
#pragma unroll
        for (int j = 0; j < 8; ++j) { u32x2 w; w.x = cvt_pk_bf16(cur[j][0], cur[j][1]); w.y = cvt_pk_bf16(cur[j][2], cur[j][3]);
            *(u32x2*)(dst + 128 * j) = w; *(u32x2*)(tile + row * 1032 + 128 * j + 4 * seg) = w; }
        const int nxt = grp + gridDim.x;
        if (nxt < T_TOK / 16) { const float* src = xrow(p, nxt * 16 + row) + 4 * seg;
#pragma unroll
            for (int j = 0; j < 8; ++j) cur[j] = __builtin_nontemporal_load((const f32x4*)(src + 128 * j)); }
        __syncthreads();
        { f32x4 acc = (f32x4){0.f, 0.f, 0.f, 0.f};
#pragma unroll
          for (int ks = 0; ks < 4; ++ks) { const bf16x8 af = *(const bf16x8*)(tile + c * 1032 + 128 * wid + 32 * ks + 8 * g), bfr = *(const bf16x8*)(wg + c * 1032 + 128 * wid + 32 * ks + 8 * g);
              acc = __builtin_amdgcn_mfma_f32_16x16x32_bf16(af, bfr, acc, 0, 0, 0); }
#pragma unroll
          for (int i = 0; i < 4; ++i) red[wid * 256 + (4 * g + i) * 16 + c] = acc[i]; }
        __syncthreads();
        if (tid < 256) { float sum = 0.f;
#pragma unroll
            for (int w = 0; w < 8; ++w) sum += red[w * 256 + tid];
            gates[(size_t)grp * 256 + tid] = sum; }
        __syncthreads();
    }
}

__device__ __forceinline__ void phase_na(const Params& p, unsigned char* smem) {
    float* rpbs = (float*)smem;
    const int tid = opaque_tid(), wid = tid >> 6, lane = tid & 63, c = lane & 15, g = lane >> 4;
    for (int i = tid; i < 8 * 15 * 31; i += 512) rpbs[i] = p.rpb[i];
    __syncthreads();
    const bf16_t* QK = (const bf16_t*)(p.ws + OFF_NA2);
    const bf16_t* VT = (const bf16_t*)(p.ws + OFF_VT);
    bf16_t* mix = (bf16_t*)(p.ws + OFF_MIX);
    const bool xcd_order = (gridDim.x == 256);
    const int nsteps = xcd_order ? 12 : (3072 + (int)gridDim.x - 1) / (int)gridDim.x;
    for (int step = 0; step < nsteps; ++step) {
        int plane, rp2;
        if (xcd_order) { const int xcd = blockIdx.x & 7, idx = blockIdx.x >> 3; plane = xcd * 48 + step * 4 + (idx >> 3); rp2 = idx & 7; }
        else { const int sid = step * (int)gridDim.x + (int)blockIdx.x; if (sid >= 3072) break; plane = sid >> 3; rp2 = sid & 7; }
        const int b = plane >> 3, h = plane & 7;
        const int r0 = 2 * (2 * rp2 + (wid >> 2)), cb = wid & 3;
        const int rsA = min(max(r0 - 4, 0), 24), rsB = min(max(r0 - 3, 0), 24), dB = rsB - rsA;
        const int kc0 = min(max(cb * 16 - 8, 0), 32);
        const int qc = cb * 16 + c, tokqA = b * SEQL + r0 * 64 + qc, tokqB = tokqA + 64;
        bf16x8 qA[2], qB[2];
#pragma unroll
        for (int ks = 0; ks < 2; ++ks) {
            qA[ks] = *(const bf16x8*)(QK + (size_t)h * ((size_t)T_TOK * 64) + (size_t)(tokqA >> 3) * 512 + ks * 256 + (tokqA & 7) * 32 + 8 * g);
            qB[ks] = *(const bf16x8*)(QK + (size_t)h * ((size_t)T_TOK * 64) + (size_t)(tokqB >> 3) * 512 + ks * 256 + (tokqB & 7) * 32 + 8 * g); }
        const int th = c + (cb == 0 ? -8 : (cb == 3 ? 8 : 0));
        bool use0[4]; int dcs[4];
#pragma unroll
        for (int i = 0; i < 4; ++i) { use0[i] = (4 * g + i) >= th; const int kc = kc0 + 4 * g + i + (use0[i] ? 0 : 16); dcs[i] = kc - qc + 15; }
        float sA[8][4], tB[9][4];
        {
            const bf16_t* kplane = QK + (size_t)(8 + h) * ((size_t)T_TOK * 64) + (c & 7) * 32 + 8 * g;
            const size_t tok0 = (size_t)b * SEQL + kc0 + c;
#pragma unroll
            for (int jj = 0; jj < 9; ++jj) {
                const int row = min(rsA + jj, 31);
                const bf16_t* kb = kplane + ((tok0 + row * 64) >> 3) * 512;
                bf16x8 kf[2][2];
#pragma unroll
                for (int kt = 0; kt < 2; ++kt)
#pragma unroll
                    for (int ks = 0; ks < 2; ++ks) kf[kt][ks] = *(const bf16x8*)(kb + kt * 2 * 512 + ks * 256);
                f32x4 aA[2], aB[2];
#pragma unroll
                for (int kt = 0; kt < 2; ++kt) {
                    aA[kt] = (f32x4){0.f, 0.f, 0.f, 0.f}; aB[kt] = (f32x4){0.f, 0.f, 0.f, 0.f};
#pragma unroll
                    for (int ks = 0; ks < 2; ++ks) { if (jj < 8) aA[kt] = __builtin_amdgcn_mfma_f32_16x16x32_bf16(kf[kt][ks], qA[ks], aA[kt], 0, 0, 0);
                        aB[kt] = __builtin_amdgcn_mfma_f32_16x16x32_bf16(kf[kt][ks], qB[ks], aB[kt], 0, 0, 0); } }
#pragma unroll
                for (int i = 0; i < 4; ++i) { if (jj < 8) sA[jj][i] = use0[i] ? aA[0][i] : aA[1][i]; tB[jj][i] = use0[i] ? aB[0][i] : aB[1][i]; }
            }
        }
        float sB[8][4];
#pragma unroll
        for (int j = 0; j < 8; ++j) {
            const float* browA = rpbs + (h * 15 + (rsA + j - r0 + 7)) * 31;
            const float* browB = rpbs + (h * 15 + (rsB + j - r0 + 6)) * 31;
#pragma unroll
            for (int i = 0; i < 4; ++i) { sA[j][i] = sA[j][i] * 0.125f + browA[dcs[i]]; sB[j][i] = (dB ? tB[j + 1][i] : tB[j][i]) * 0.125f + browB[dcs[i]]; }
        }
        float mxA = -1e30f, mxB = -1e30f;
#pragma unroll
        for (int j = 0; j < 8; ++j)
#pragma unroll
            for (int i = 0; i < 4; ++i) { mxA = fmaxf(mxA, sA[j][i]); mxB = fmaxf(mxB, sB[j][i]); }
        mxA = fmaxf(mxA, __shfl_xor(mxA, 16)); mxA = fmaxf(mxA, __shfl_xor(mxA, 32));
        mxB = fmaxf(mxB, __shfl_xor(mxB, 16)); mxB = fmaxf(mxB, __shfl_xor(mxB, 32));
        float sumA = 0.f, sumB = 0.f;
        unsigned pA[8][2], pB[8][2];
#pragma unroll
        for (int j = 0; j < 8; ++j) { float eA[4], eB[4];
#pragma unroll
            for (int i = 0; i < 4; ++i) { eA[i] = __expf(sA[j][i] - mxA); sumA += eA[i]; eB[i] = __expf(sB[j][i] - mxB); sumB += eB[i]; }
            pA[j][0] = cvt_pk_bf16(eA[0], eA[1]); pA[j][1] = cvt_pk_bf16(eA[2], eA[3]); pB[j][0] = cvt_pk_bf16(eB[0], eB[1]); pB[j][1] = cvt_pk_bf16(eB[2], eB[3]); }
        sumA += __shfl_xor(sumA, 16); sumA += __shfl_xor(sumA, 32);
        sumB += __shfl_xor(sumB, 16); sumB += __shfl_xor(sumB, 32);
        f32x4 oA[4], oB[4];
#pragma unroll
        for (int mt = 0; mt < 4; ++mt) { oA[mt] = (f32x4){0.f, 0.f, 0.f, 0.f}; oB[mt] = (f32x4){0.f, 0.f, 0.f, 0.f}; }
        {
            const bf16_t* vplane = VT + (size_t)h * ((size_t)T_TOK * 64) + c * 4;
            const size_t tk0 = (size_t)b * SEQL + kc0 + 4 * g;
#pragma unroll
            for (int jj = 0; jj < 9; ++jj) {
                const int row = min(rsA + jj, 31);
                const bf16_t* vb = vplane + ((tk0 + row * 64) >> 2) * 256;
                u32x2 vlo[4], vhi[4];
#pragma unroll
                for (int mt = 0; mt < 4; ++mt) { vlo[mt] = *(const u32x2*)(vb + mt * 64); vhi[mt] = *(const u32x2*)(vb + mt * 64 + 1024); }
                unsigned b01, b23;
                if (jj == 0) { b01 = dB ? 0u : pB[0][0]; b23 = dB ? 0u : pB[0][1]; }
                else if (jj == 8) { b01 = dB ? pB[7][0] : 0u; b23 = dB ? pB[7][1] : 0u; }
                else { b01 = dB ? pB[jj - 1][0] : pB[jj][0]; b23 = dB ? pB[jj - 1][1] : pB[jj][1]; }
                u32x4 pwB;
                pwB.x = (use0[0] ? (b01 & 0xffffu) : 0u) | (use0[1] ? (b01 & 0xffff0000u) : 0u);
                pwB.y = (use0[2] ? (b23 & 0xffffu) : 0u) | (use0[3] ? (b23 & 0xffff0000u) : 0u);
                pwB.z = (use0[0] ? 0u : (b01 & 0xffffu)) | (use0[1] ? 0u : (b01 & 0xffff0000u));
                pwB.w = (use0[2] ? 0u : (b23 & 0xffffu)) | (use0[3] ? 0u : (b23 & 0xffff0000u));
                u32x4 pwA = (u32x4){0u, 0u, 0u, 0u};
                if (jj < 8) { const unsigned a01 = pA[jj][0], a23 = pA[jj][1];
                    pwA.x = (use0[0] ? (a01 & 0xffffu) : 0u) | (use0[1] ? (a01 & 0xffff0000u) : 0u);
                    pwA.y = (use0[2] ? (a23 & 0xffffu) : 0u) | (use0[3] ? (a23 & 0xffff0000u) : 0u);
                    pwA.z = (use0[0] ? 0u : (a01 & 0xffffu)) | (use0[1] ? 0u : (a01 & 0xffff0000u));
                    pwA.w = (use0[2] ? 0u : (a23 & 0xffffu)) | (use0[3] ? 0u : (a23 & 0xffff0000u)); }
#pragma unroll
                for (int mt = 0; mt < 4; ++mt) {
                    u32x4 vw; vw.x = vlo[mt].x; vw.y = vlo[mt].y; vw.z = vhi[mt].x; vw.w = vhi[mt].y;
                    if (jj < 8) oA[mt] = __builtin_amdgcn_mfma_f32_16x16x32_bf16(as_bf16x8(vw), as_bf16x8(pwA), oA[mt], 0, 0, 0);
                    oB[mt] = __builtin_amdgcn_mfma_f32_16x16x32_bf16(as_bf16x8(vw), as_bf16x8(pwB), oB[mt], 0, 0, 0); }
            }
        }
        const float invA = __builtin_amdgcn_rcpf(sumA), invB = __builtin_amdgcn_rcpf(sumB);
#pragma unroll
        for (int mt = 0; mt < 4; ++mt) {
            u32x2 w; w.x = cvt_pk_bf16(oA[mt][0] * invA, oA[mt][1] * invA); w.y = cvt_pk_bf16(oA[mt][2] * invA, oA[mt][3] * invA);
            *(u32x2*)(mix + (size_t)tokqA * 1024 + h * 64 + mt * 16 + 4 * g) = w;
            u32x2 w2; w2.x = cvt_pk_bf16(oB[mt][0] * invB, oB[mt][1] * invB); w2.y = cvt_pk_bf16(oB[mt][2] * invB, oB[mt][3] * invB);
            *(u32x2*)(mix + (size_t)tokqB * 1024 + h * 64 + mt * 16 + 4 * g) = w2; }
    }
}

typedef short bf16x4 __attribute__((ext_vector_type(4)));
__device__ __forceinline__ bf16x4 as_bf16x4(u32x2 v) { union { u32x2 u; bf16x4 b; } c; c.u = v; return c.b; }
__device__ __forceinline__ float sel4(float a0, float a1, float a2, float a3, int k) { return k == 0 ? a0 : (k == 1 ? a1 : (k == 2 ? a2 : a3)); }
constexpr int PL_KS = 0, PL_VS = 17408, PL_QS = 34816, PL_M1 = 52224, PL_M2 = 68864, PL_XT = 34816, PL_LB = 85504, PL_DT = 103936, PL_GC = 112128, PL_BETA = 112640, PL_EGC = 113152, PL_EGL = 113664, PL_BEG = 114176, PL_WS = 114688, PL_TB = 122880;

template <int D>
__device__ __forceinline__ void prep_attn(const int tid, unsigned char* smem, unsigned char* prep, const int bl, const int h, const int n) {
    const float* M1 = (const float*)(smem + PL_M1); const float* M2 = (const float*)(smem + PL_M2);
    bf16_t* Lb = (bf16_t*)(smem + PL_LB) + D * 64 * 72; float* DT = (float*)(smem + PL_DT) + D * 1024;
    const float* gcs = (const float*)(smem + PL_GC) + D * 64; const float* betas = (const float*)(smem + PL_BETA) + D * 64;
    const size_t pidx = ((size_t)(bl * 4 + h) * 2 + D) * 32 + (D ? 31 - n : n);
    unsigned char* pout = prep + pidx * PREP_ITEM;
    const int t = tid & 255, ip = t >> 2, jb = (t & 3) * 16;
    const float gi = gcs[ip], bi = betas[ip]; const int oi = D ? 63 - ip : ip;
    const float* m1r = M1 + oi * 65 + (D ? 63 - jb : jb); const float* m2r = M2 + oi * 65 + (D ? 63 - jb : jb);
    float av[16], lv[16];
#pragma unroll
    for (int jj = 0; jj < 16; ++jj) { const int jp = jb + jj;
        const float dec = (ip >= jp) ? __expf(gi - gcs[jp]) : 0.f;
        lv[jj] = (ip > jp) ? bi * m1r[D ? -jj : jj] * dec : 0.f;
        av[jj] = m2r[D ? -jj : jj] * dec; }
    { u32x4 w0, w1; w0.x = cvt_pk_bf16(lv[0], lv[1]); w0.y = cvt_pk_bf16(lv[2], lv[3]); w0.z = cvt_pk_bf16(lv[4], lv[5]); w0.w = cvt_pk_bf16(lv[6], lv[7]);
      w1.x = cvt_pk_bf16(lv[8], lv[9]); w1.y = cvt_pk_bf16(lv[10], lv[11]); w1.z = cvt_pk_bf16(lv[12], lv[13]); w1.w = cvt_pk_bf16(lv[14], lv[15]);
      *(u32x4*)(Lb + ip * 72 + jb) = w0; *(u32x4*)(Lb + ip * 72 + jb + 8) = w1; }
    if ((ip >> 4) == (jb >> 4)) { float* dt = DT + (ip >> 4) * 256 + (ip & 15);
#pragma unroll
        for (int jj = 0; jj < 16; ++jj) dt[jj * 16] = lv[jj]; }
    bf16_t* arow = (bf16_t*)(pout + PI_ATTN) + ip * 64 + (jb & 32) + ((jb >> 4) & 1) * 4;
#pragma unroll
    for (int gg = 0; gg < 4; ++gg) { u32x2 w; w.x = cvt_pk_bf16(av[4 * gg], av[4 * gg + 1]); w.y = cvt_pk_bf16(av[4 * gg + 2], av[4 * gg + 3]); *(u32x2*)(arow + 8 * gg) = w; }
}
template <int D>
__device__ __forceinline__ void prep_qdk(const int tid, unsigned char* smem, unsigned char* prep, float* cdarr, const int bl, const int h, const int n) {
    const bf16_t* qs = (const bf16_t*)(smem + PL_QS); const bf16_t* ks = (const bf16_t*)(smem + PL_KS);
    const float* gcs = (const float*)(smem + PL_GC) + D * 64;
    const size_t pidx = ((size_t)(bl * 4 + h) * 2 + D) * 32 + (D ? 31 - n : n);
    unsigned char* pout = prep + pidx * PREP_ITEM;
    const float* egc = (const float*)(smem + PL_EGC) + D * 64; const float* egl = (const float*)(smem + PL_EGL) + D * 64;
    const int t = tid & 255;
#pragma unroll
    for (int rep = 0; rep < 4; ++rep) { const int id = t + rep * 256, ip = id >> 4, q = id & 15, kt = q >> 2, gg = q & 3, oi = D ? 63 - ip : ip;
        const float e = egc[ip];
        const u32x2 lo = *(const u32x2*)(qs + oi * 136 + kt * 32 + 4 * gg), hi = *(const u32x2*)(qs + oi * 136 + kt * 32 + 16 + 4 * gg);
        u32x4 w; w.x = cvt_pk_bf16(bflo(lo.x) * e, bfhi(lo.x) * e); w.y = cvt_pk_bf16(bflo(lo.y) * e, bfhi(lo.y) * e);
        w.z = cvt_pk_bf16(bflo(hi.x) * e, bfhi(hi.x) * e); w.w = cvt_pk_bf16(bflo(hi.y) * e, bfhi(hi.y) * e);
        *(u32x4*)((bf16_t*)(pout + PI_QD) + ip * 128 + q * 8) = w; }
#pragma unroll
    for (int rep = 0; rep < 4; ++rep) { const int id = t + rep * 256, dk = id >> 3, q = id & 7, kt = q >> 2, gg = q & 3;
        float v[8];
#pragma unroll
        for (int sidx = 0; sidx < 8; ++sidx) { const int ip = kt * 32 + (sidx >> 2) * 16 + 4 * gg + (sidx & 3), oi = D ? 63 - ip : ip;
            v[sidx] = bf2f(ks[oi * 136 + dk]) * egl[ip]; }
        u32x4 w; w.x = cvt_pk_bf16(v[0], v[1]); w.y = cvt_pk_bf16(v[2], v[3]); w.z = cvt_pk_bf16(v[4], v[5]); w.w = cvt_pk_bf16(v[6], v[7]);
        *(u32x4*)((bf16_t*)(pout + PI_KDT) + dk * 64 + q * 8) = w; }
    if (t == 0) cdarr[pidx] = egc[63];
}
__device__ __forceinline__ void prep_inv(const int t, unsigned char* smem) {
    const int d = t >> 6, blk = (t >> 4) & 3, jj = t & 15;
    const float* DTb = (const float*)(smem + PL_DT) + d * 1024 + blk * 256;
    bf16_t* Tb = (bf16_t*)(smem + PL_TB) + (d * 4 + blk) * 256;
    float y[16];
#pragma unroll
    for (int i = 0; i < 16; ++i) y[i] = (i == jj) ? 1.f : 0.f;
#pragma unroll
    for (int k = 0; k < 15; ++k) { const float yk = y[k];
#pragma unroll
        for (int i4 = (k + 1) / 4; i4 < 4; ++i4) { const f32x4 a = *(const f32x4*)(DTb + k * 16 + i4 * 4);
#pragma unroll
            for (int q = 0; q < 4; ++q) if (i4 * 4 + q > k) y[i4 * 4 + q] -= a[q] * yk; } }
#pragma unroll
    for (int i = 0; i < 16; ++i) Tb[i * 16 + jj] = f2bf(y[i]);
}
template <int D>
__device__ __forceinline__ void prep_solve(const int tid, unsigned char* smem, unsigned char* prep, const int bl, const int h, const int n) {
    const bf16_t* ks = (const bf16_t*)(smem + PL_KS); const bf16_t* vs = (const bf16_t*)(smem + PL_VS);
    const bf16_t* Lb = (const bf16_t*)(smem + PL_LB) + D * 64 * 72; const bf16_t* Tb = (const bf16_t*)(smem + PL_TB) + D * 1024;
    bf16_t* XT = (bf16_t*)(smem + PL_XT) + D * 256 * 48;
    const size_t pidx = ((size_t)(bl * 4 + h) * 2 + D) * 32 + (D ? 31 - n : n);
    unsigned char* pout = prep + pidx * PREP_ITEM;
    const int w4 = (tid >> 6) & 3, lane = tid & 63, c = lane & 15, g = lane >> 4;
    const bool isw = w4 >= 2; const bf16_t* src = (isw ? ks : vs) + ((64 * w4 + c) & 127);
    const float* scl = (const float*)(smem + (isw ? PL_BEG : PL_BETA)) + D * 64;
    bf16_t* wst = (bf16_t*)(smem + PL_WS) + (D * 2 + (w4 & 1)) * 1024;
#pragma unroll 1
    for (int r = 0; r < 4; ++r) {
        f32x4 acc[4];
#pragma unroll
        for (int nt = 0; nt < 4; ++nt) acc[nt] = (f32x4){0.f, 0.f, 0.f, 0.f};
        for (int kk = 0; kk < r; ++kk) {
            const bf16x4 af = as_bf16x4(*(const u32x2*)(Lb + (16 * r + c) * 72 + 16 * kk + 4 * g));
#pragma unroll
            for (int nt = 0; nt < 4; ++nt) { const bf16x4 bfr = as_bf16x4(*(const u32x2*)(XT + (64 * w4 + 16 * nt + c) * 48 + 16 * kk + 4 * g));
                acc[nt] = __builtin_amdgcn_mfma_f32_16x16x16bf16_1k(af, bfr, acc[nt], 0, 0, 0); }
        }
        const f32x4 sc4 = *(const f32x4*)(scl + 16 * r + 4 * g);
        const bf16x4 tf = as_bf16x4(*(const u32x2*)(Tb + r * 256 + c * 16 + 4 * g));
        f32x4 X[4];
#pragma unroll
        for (int nt = 0; nt < 4; ++nt) { float rr[4];
#pragma unroll
            for (int i = 0; i < 4; ++i) { const int tok = 16 * r + 4 * g + i, oi = D ? 63 - tok : tok; rr[i] = bf2f(src[oi * 136 + 16 * nt]) * sc4[i] - acc[nt][i]; }
            u32x2 rb; rb.x = cvt_pk_bf16(rr[0], rr[1]); rb.y = cvt_pk_bf16(rr[2], rr[3]);
            X[nt] = __builtin_amdgcn_mfma_f32_16x16x16bf16_1k(tf, as_bf16x4(rb), (f32x4){0.f, 0.f, 0.f, 0.f}, 0, 0, 0); }
        u32x2 xb[4];
#pragma unroll
        for (int nt = 0; nt < 4; ++nt) { xb[nt].x = cvt_pk_bf16(X[nt][0], X[nt][1]); xb[nt].y = cvt_pk_bf16(X[nt][2], X[nt][3]); }
        if (r < 3) {
#pragma unroll
            for (int nt = 0; nt < 4; ++nt) *(u32x2*)(XT + (64 * w4 + 16 * nt + c) * 48 + 16 * r + 4 * g) = xb[nt]; }
        if (!isw) {
#pragma unroll
            for (int nt = 0; nt < 4; ++nt) *(u32x2*)((bf16_t*)(pout + PI_UT) + (64 * w4 + 16 * nt + c) * 64 + 16 * r + 4 * g) = xb[nt]; }
        else {
#pragma unroll
            for (int nt = 0; nt < 4; ++nt) { const int pc = perm_k(64 * (w4 & 1) + 16 * nt + c) & 63;
                wst[(4 * g + 0) * 64 + pc] = (bf16_t)(xb[nt].x & 0xffffu); wst[(4 * g + 1) * 64 + pc] = (bf16_t)(xb[nt].x >> 16);
                wst[(4 * g + 2) * 64 + pc] = (bf16_t)(xb[nt].y & 0xffffu); wst[(4 * g + 3) * 64 + pc] = (bf16_t)(xb[nt].y >> 16); }
#pragma unroll
            for (int rep = 0; rep < 2; ++rep) { const int q = lane + 64 * rep, row = q >> 3, ch = q & 7;
                const u32x4 v = *(const u32x4*)(wst + row * 64 + ch * 8);
                *(u32x4*)((bf16_t*)(pout + PI_W) + (16 * r + row) * 128 + 64 * (w4 & 1) + ch * 8) = v; }
        }
    }
}

__device__ __forceinline__ void phase_prep(const Params& p, int grp, unsigned char* smem_base) {
    const bf16_t* seg = (const bf16_t*)(p.ws + OFF_SEG);
    const float* gates = (const float*)((const unsigned char*)p.out + OOFF_GATES);
    unsigned char* prep = p.ws + OFF_PREP; float* cdarr = (float*)(p.ws + OFF_CD);
    u32x4 rows_nx[12];
    { const int tid0 = opaque_tid(), it0 = blockIdx.x;
#pragma unroll
      for (int rr = 0; rr < 12; ++rr) rows_nx[rr] = (u32x4){0u, 0u, 0u, 0u};
      if (tid0 < 384 && it0 < 3072) { const int which = tid0 >> 7, tb = (tid0 & 127) >> 4, cgp = tid0 & 15, hn = it0 & 3, nn = (it0 >> 2) & 31, bn = grp * 24 + (it0 >> 7);
#pragma unroll
        for (int rr = 0; rr < 12; ++rr) { const int pos = nn * 64 + tb * 8 - 2 + rr;
            if (pos >= 0 && pos < SEQL) rows_nx[rr] = *(const u32x4*)(seg + which * 512 + ((size_t)bn * SEQL + pos) * 1536 + hn * 128 + cgp * 8); } } }
    for (int it = blockIdx.x; it < 3072; it += gridDim.x) {
        const int h = it & 3, n = (it >> 2) & 31, bl = it >> 7, b = grp * 24 + bl;
        const int tid = opaque_tid();
        const int wid = tid >> 6, lane = tid & 63, c = lane & 15, g = lane >> 4;
        int lofs = 0; asm volatile("" : "+s"(lofs));
        unsigned char* smem = smem_base + lofs;
        bf16_t* qs = (bf16_t*)(smem + PL_QS); bf16_t* ks = (bf16_t*)(smem + PL_KS); bf16_t* vs = (bf16_t*)(smem + PL_VS);
        float* M1 = (float*)(smem + PL_M1); float* M2 = (float*)(smem + PL_M2);
        float* gcs = (float*)(smem + PL_GC); float* betas = (float*)(smem + PL_BETA);
        const size_t tok0 = (size_t)b * SEQL + n * 64;
        if (tid < 384) {
            const int which = tid >> 7, tb = (tid & 127) >> 4, cgp = tid & 15, chan = h * 128 + cgp * 8;
            const bf16_t* sg = seg + which * 512;
            float cw[5][8];
#pragma unroll
            for (int j = 0; j < 5; ++j) { const f32x4 w0 = *(const f32x4*)(p.gconv + j * 1536 + which * 512 + chan), w1 = *(const f32x4*)(p.gconv + j * 1536 + which * 512 + chan + 4);
                cw[j][0] = w0[0]; cw[j][1] = w0[1]; cw[j][2] = w0[2]; cw[j][3] = w0[3]; cw[j][4] = w1[0]; cw[j][5] = w1[1]; cw[j][6] = w1[2]; cw[j][7] = w1[3]; }
            u32x4 rows[12];
#pragma unroll
            for (int rr = 0; rr < 12; ++rr) rows[rr] = rows_nx[rr];
            bf16_t* dst = (which == 0 ? qs : (which == 1 ? ks : vs)) + cgp * 8;
#pragma unroll
            for (int tt = 0; tt < 8; ++tt) {
                float y[8];
#pragma unroll
                for (int e = 0; e < 8; ++e) y[e] = 0.f;
#pragma unroll
                for (int j = 0; j < 5; ++j) { const u32x4 rv = rows[tt + j];
                    y[0] += cw[j][0] * bflo(rv.x); y[1] += cw[j][1] * bfhi(rv.x); y[2] += cw[j][2] * bflo(rv.y); y[3] += cw[j][3] * bfhi(rv.y);
                    y[4] += cw[j][4] * bflo(rv.z); y[5] += cw[j][5] * bfhi(rv.z); y[6] += cw[j][6] * bflo(rv.w); y[7] += cw[j][7] * bfhi(rv.w); }
                float ss = 0.f;
#pragma unroll
                for (int e = 0; e < 8; ++e) { y[e] = silu_f(y[e]); ss += y[e] * y[e]; }
                ss += __shfl_xor(ss, 1); ss += __shfl_xor(ss, 2); ss += __shfl_xor(ss, 4); ss += __shfl_xor(ss, 8);
                const float sc = (which == 0) ? rsqrtf(ss + 1e-6f) * 0.08838834764831845f : ((which == 1) ? rsqrtf(ss + 1e-6f) : 1.f);
                u32x4 w; w.x = cvt_pk_bf16(y[0] * sc, y[1] * sc); w.y = cvt_pk_bf16(y[2] * sc, y[3] * sc); w.z = cvt_pk_bf16(y[4] * sc, y[5] * sc); w.w = cvt_pk_bf16(y[6] * sc, y[7] * sc);
                *(u32x4*)(dst + (tb * 8 + tt) * 136) = w;
            }
            { const int itn = it + gridDim.x;
              if (itn < 3072) { const int hn = itn & 3, nn = (itn >> 2) & 31, bn = grp * 24 + (itn >> 7);
#pragma unroll
                for (int rr = 0; rr < 12; ++rr) { const int pos = nn * 64 + tb * 8 - 2 + rr; rows_nx[rr] = (u32x4){0u, 0u, 0u, 0u};
                    if (pos >= 0 && pos < SEQL) rows_nx[rr] = *(const u32x4*)(seg + which * 512 + ((size_t)bn * SEQL + pos) * 1536 + hn * 128 + cgp * 8); } } }
        } else if (wid >= 6) {
            const int d = wid - 6, li = d ? 63 - lane : lane;
            const float* gr = gates + (tok0 + li) * 16;
            const float bet = sigmoid_f(gr[d * 4 + h]);
            const float a = gr[8 + d * 4 + h] + p.dt_bias[d * 4 + h];
            const float sp = fmaxf(a, 0.f) + log1pf(__expf(-fabsf(a)));
            float gv = -__expf(p.a_log[d * 4 + h]) * sp;
#pragma unroll
            for (int off = 1; off < 64; off <<= 1) { const float t = __shfl_up(gv, off); if (lane >= off) gv += t; }
            gcs[d * 64 + lane] = gv; betas[d * 64 + lane] = bet;
            { const float eg = __expf(gv), gl = __shfl(gv, 63);
              ((float*)(smem + PL_EGC))[d * 64 + lane] = eg; ((float*)(smem + PL_EGL))[d * 64 + lane] = __expf(gl - gv); ((float*)(smem + PL_BEG))[d * 64 + lane] = bet * eg; }
        }
        __syncthreads();
        {
            const int which = wid >> 2, mt = wid & 3; const bf16_t* X = which ? qs : ks; float* M = which ? M2 : M1;
            bf16x8 af[4];
#pragma unroll
            for (int kk = 0; kk < 4; ++kk) af[kk] = *(const bf16x8*)(X + (mt * 16 + c) * 136 + kk * 32 + 8 * g);
#pragma unroll
            for (int nt = 0; nt < 4; ++nt) { f32x4 a = (f32x4){0.f, 0.f, 0.f, 0.f};
#pragma unroll
                for (int kk = 0; kk < 4; ++kk) { const bf16x8 bfr = *(const bf16x8*)(ks + (nt * 16 + c) * 136 + kk * 32 + 8 * g);
                    a = __builtin_amdgcn_mfma_f32_16x16x32_bf16(af[kk], bfr, a, 0, 0, 0); }
#pragma unroll
                for (int i = 0; i < 4; ++i) M[(mt * 16 + 4 * g + i) * 65 + nt * 16 + c] = a[i]; }
        }
        __syncthreads();
        if (tid < 256) prep_attn<0>(tid, smem, prep, bl, h, n); else prep_attn<1>(tid, smem, prep, bl, h, n);
        __syncthreads();
        if (tid < 128) prep_inv(tid, smem);
        if (tid < 256) prep_qdk<0>(tid, smem, prep, cdarr, bl, h, n); else prep_qdk<1>(tid, smem, prep, cdarr, bl, h, n);
        __syncthreads();
        if (tid < 256) prep_solve<0>(tid, smem, prep, bl, h, n); else prep_solve<1>(tid, smem, prep, bl, h, n);
        __syncthreads();
    }
}

constexpr int SL_W = 0, SL_QD = 17408, SL_ATTN = 34816, SL_KDT = 44032;
__device__ __forceinline__ void phase_scan(const Params& p, int grp, unsigned char* smem) {
    const int tid = opaque_tid(), wv = tid >> 6, lane = tid & 63, c = lane & 15, g = lane >> 4;
    const unsigned char* prep = p.ws + OFF_PREP; const float* cdarr = (const float*)(p.ws + OFF_CD);
    bf16_t* O4 = (bf16_t*)((unsigned char*)p.out + OOFF_O);
    (void)grp;
    constexpr int SBUF = 62464;
    for (int it = blockIdx.x; it < 192; it += gridDim.x) {
        const int d = it & 1, h = (it >> 1) & 3, bl = it >> 3;
        const unsigned char* pbase = prep + (size_t)it * 32 * PREP_ITEM; const float* cdp = cdarr + (size_t)it * 32;
        f32x4 S[8];
#pragma unroll
        for (int m = 0; m < 8; ++m) S[m] = (f32x4){0.f, 0.f, 0.f, 0.f};
        u32x4 st[7];
#define SCAN_LOAD(src) do { _Pragma("unroll") for (int k = 0; k < 7; ++k) st[k] = __builtin_nontemporal_load((const u32x4*)((src) + (size_t)(tid + 512 * k) * 16)); } while (0)
#define SCAN_STORE(sb) do { \
        _Pragma("unroll") for (int k = 0; k < 2; ++k) { const int id = tid + 512 * k; *(u32x4*)((sb) + SL_W + (id >> 4) * 272 + (id & 15) * 16) = st[k]; } \
        _Pragma("unroll") for (int k = 2; k < 4; ++k) { const int id = tid + 512 * (k - 2); *(u32x4*)((sb) + SL_QD + (id >> 4) * 272 + (id & 15) * 16) = st[k]; } \
        { const int id = tid; *(u32x4*)((sb) + SL_ATTN + (id >> 3) * 144 + (id & 7) * 16) = st[4]; } \
        _Pragma("unroll") for (int k = 5; k < 7; ++k) { const int id = tid + 512 * (k - 5); *(u32x4*)((sb) + SL_KDT + (id >> 3) * 144 + (id & 7) * 16) = st[k]; } } while (0)
        SCAN_LOAD(pbase); SCAN_STORE(smem);
        SCAN_LOAD(pbase + PREP_ITEM);
        u32x2 uun[4]; float cdn = cdp[0];
#pragma unroll
        for (int mt = 0; mt < 4; ++mt) uun[mt] = *(const u32x2*)(pbase + PI_UT + ((16 * wv + c) * 64 + 16 * mt + 4 * g) * 2);
        __syncthreads();
        for (int n = 0; n < 32; ++n) {
            const unsigned char* cur = pbase + (size_t)n * PREP_ITEM;
            unsigned char* sb = smem + (n & 1) * SBUF;
            if (n < 31) SCAN_STORE(smem + ((n + 1) & 1) * SBUF);
            if (n < 30) SCAN_LOAD(cur + 2 * PREP_ITEM);
            u32x2 uu[4]; const float cdv = cdn;
#pragma unroll
            for (int mt = 0; mt < 4; ++mt) uu[mt] = uun[mt];
            if (n < 31) { cdn = cdp[n + 1];
#pragma unroll
                for (int mt = 0; mt < 4; ++mt) uun[mt] = *(const u32x2*)(cur + PREP_ITEM + PI_UT + ((16 * wv + c) * 64 + 16 * mt + 4 * g) * 2); }
            bf16x8 Sb[4];
#pragma unroll
            for (int kt = 0; kt < 4; ++kt) { u32x4 w; w.x = cvt_pk_bf16(S[2 * kt][0], S[2 * kt][1]); w.y = cvt_pk_bf16(S[2 * kt][2], S[2 * kt][3]);
                w.z = cvt_pk_bf16(S[2 * kt + 1][0], S[2 * kt + 1][1]); w.w = cvt_pk_bf16(S[2 * kt + 1][2], S[2 * kt + 1][3]); Sb[kt] = as_bf16x8(w); }
            f32x4 av[4], ao[4];
#pragma unroll
            for (int mt = 0; mt < 4; ++mt) { f32x4 a = (f32x4){0.f, 0.f, 0.f, 0.f};
#pragma unroll
                for (int kt = 0; kt < 4; ++kt) { const bf16x8 af = *(const bf16x8*)(sb + SL_W + (16 * mt + c) * 272 + (32 * kt + 8 * g) * 2);
                    a = __builtin_amdgcn_mfma_f32_16x16x32_bf16(af, Sb[kt], a, 0, 0, 0); }
                av[mt] = a; }
#pragma unroll
            for (int mt = 0; mt < 4; ++mt) { f32x4 a = (f32x4){0.f, 0.f, 0.f, 0.f};
#pragma unroll
                for (int kt = 0; kt < 4; ++kt) { const bf16x8 af = *(const bf16x8*)(sb + SL_QD + (16 * mt + c) * 272 + (32 * kt + 8 * g) * 2);
                    a = __builtin_amdgcn_mfma_f32_16x16x32_bf16(af, Sb[kt], a, 0, 0, 0); }
                ao[mt] = a; }
            f32x4 v[4];
#pragma unroll
            for (int mt = 0; mt < 4; ++mt) v[mt] = (f32x4){bflo(uu[mt].x) - av[mt][0], bfhi(uu[mt].x) - av[mt][1], bflo(uu[mt].y) - av[mt][2], bfhi(uu[mt].y) - av[mt][3]};
            bf16x8 Vb[2];
#pragma unroll
            for (int kt = 0; kt < 2; ++kt) { u32x4 w; w.x = cvt_pk_bf16(v[2 * kt][0], v[2 * kt][1]); w.y = cvt_pk_bf16(v[2 * kt][2], v[2 * kt][3]);
                w.z = cvt_pk_bf16(v[2 * kt + 1][0], v[2 * kt + 1][1]); w.w = cvt_pk_bf16(v[2 * kt + 1][2], v[2 * kt + 1][3]); Vb[kt] = as_bf16x8(w); }
            const int no = d ? 31 - n : n;
#pragma unroll
            for (int mt = 0; mt < 4; ++mt) { f32x4 a = ao[mt];
#pragma unroll
                for (int kt = 0; kt < 2; ++kt) { const bf16x8 af = *(const bf16x8*)(sb + SL_ATTN + (16 * mt + c) * 144 + (32 * kt + 8 * g) * 2);
                    a = __builtin_amdgcn_mfma_f32_16x16x32_bf16(af, Vb[kt], a, 0, 0, 0); }
                ao[mt] = a; }
#pragma unroll
            for (int m8 = 0; m8 < 8; ++m8) { f32x4 a = S[m8] * cdv;
#pragma unroll
                for (int kt = 0; kt < 2; ++kt) { const bf16x8 af = *(const bf16x8*)(sb + SL_KDT + (16 * m8 + c) * 144 + (32 * kt + 8 * g) * 2);
                    a = __builtin_amdgcn_mfma_f32_16x16x32_bf16(af, Vb[kt], a, 0, 0, 0); }
                S[m8] = a; }
#pragma unroll
            for (int mt = 0; mt < 4; ++mt) {
                const int l0 = d ? 60 - 16 * mt - 4 * g : 16 * mt + 4 * g;
                u32x2 w; if (d) { w.x = cvt_pk_bf16(ao[mt][3], ao[mt][2]); w.y = cvt_pk_bf16(ao[mt][1], ao[mt][0]); }
                else { w.x = cvt_pk_bf16(ao[mt][0], ao[mt][1]); w.y = cvt_pk_bf16(ao[mt][2], ao[mt][3]); }
                *(u32x2*)(O4 + (((size_t)d * 12288 + (((size_t)bl * SEQL + no * 64 + l0) >> 2)) * 512 + h * 128 + 16 * wv + c) * 4) = w; }
            __syncthreads();
        }
#undef SCAN_LOAD
#undef SCAN_STORE
    }
}

__device__ __forceinline__ void phase_combine(const Params& p, int grp) {
    const bf16_t* O4 = (const bf16_t*)((const unsigned char*)p.out + OOFF_O);
    const bf16_t* Z = (const bf16_t*)((const unsigned char*)p.out + OOFF_Z);
    bf16_t* mix = (bf16_t*)(p.ws + OFF_MIX);
    const int total = 12288 * 4 * 32, nthr = gridDim.x * 512;
    const int q = opaque_tid() & 31;
    const f32x4 nwv = *(const f32x4*)(p.gnorm + 4 * q);
    for (int gt = blockIdx.x * 512 + opaque_tid(); gt < total; gt += nthr) {
        const int h = (gt >> 5) & 3, tg4 = gt >> 7;
        const bf16_t* of = O4 + ((size_t)tg4 * 512 + h * 128 + 4 * q) * 4; const bf16_t* ob = of + (size_t)12288 * 512 * 4;
        const u32x4 f0 = __builtin_nontemporal_load((const u32x4*)of), f1 = __builtin_nontemporal_load((const u32x4*)(of + 8)), b0 = __builtin_nontemporal_load((const u32x4*)ob), b1 = __builtin_nontemporal_load((const u32x4*)(ob + 8));
        const size_t tokg = (size_t)grp * 49152 + (size_t)tg4 * 4;
        u32x2 zv[4];
#pragma unroll
        for (int t = 0; t < 4; ++t) zv[t] = *(const u32x2*)(Z + (tokg + t) * 512 + h * 128 + 4 * q);
        const unsigned fw[8] = {f0.x, f0.y, f0.z, f0.w, f1.x, f1.y, f1.z, f1.w}, bw[8] = {b0.x, b0.y, b0.z, b0.w, b1.x, b1.y, b1.z, b1.w};
        float o[4][4];
#pragma unroll
        for (int j = 0; j < 4; ++j) { o[j][0] = bflo(fw[2 * j]) + bflo(bw[2 * j]); o[j][1] = bfhi(fw[2 * j]) + bfhi(bw[2 * j]);
            o[j][2] = bflo(fw[2 * j + 1]) + bflo(bw[2 * j + 1]); o[j][3] = bfhi(fw[2 * j + 1]) + bfhi(bw[2 * j + 1]); }
#pragma unroll
        for (int t = 0; t < 4; ++t) {
            float ss = (o[0][t] * o[0][t] + o[1][t] * o[1][t]) + (o[2][t] * o[2][t] + o[3][t] * o[3][t]);
            ss += __shfl_xor(ss, 1); ss += __shfl_xor(ss, 2); ss += __shfl_xor(ss, 4); ss += __shfl_xor(ss, 8); ss += __shfl_xor(ss, 16);
            const float r = rsqrtf(ss * (1.f / 128.f) + 1e-6f);
            const float z0 = bflo(zv[t].x), z1 = bfhi(zv[t].x), z2 = bflo(zv[t].y), z3 = bfhi(zv[t].y);
            u32x2 w; w.x = cvt_pk_bf16(o[0][t] * r * nwv[0] * silu_f(z0), o[1][t] * r * nwv[1] * silu_f(z1)); w.y = cvt_pk_bf16(o[2][t] * r * nwv[2] * silu_f(z2), o[3][t] * r * nwv[3] * silu_f(z3));
            *(u32x2*)(mix + (tokg + t) * 1024 + 512 + h * 128 + 4 * q) = w; }
    }
}

template <bool OUT_BF16, int IN_BF16>
__device__ __forceinline__ void phase_ln(const void* inp, const void* inp2, const void* inp3, void* outp, const float* gam, const float* bet, const int row_lo, const int row_hi) {
    const int tid = opaque_tid(), wid = tid >> 6, lane = tid & 63;
    f32x4 gv[4], bv[4];
#pragma unroll
    for (int j = 0; j < 4; ++j) { gv[j] = *(const f32x4*)(gam + j * 256 + lane * 4); bv[j] = *(const f32x4*)(bet + j * 256 + lane * 4); }
    for (int row0 = row_lo + (blockIdx.x * 8 + wid) * 4; row0 < row_hi; row0 += gridDim.x * 32) {
        f32x4 v[4][4]; float s[4] = {0.f, 0.f, 0.f, 0.f}, s2[4] = {0.f, 0.f, 0.f, 0.f};
#pragma unroll
        for (int rr = 0; rr < 4; ++rr)
#pragma unroll
            for (int j = 0; j < 4; ++j) {
                if (IN_BF16 == 3) { const int row = row0 + rr; const float* xr = (row < T_PROMPT) ? (const float*)inp + (size_t)row * 1024 : (const float*)inp3 + (size_t)(row - T_PROMPT) * 1024;
                    const f32x4 xv = __builtin_nontemporal_load((const f32x4*)(xr + lane * 4 + j * 256)); const u32x2 fv = __builtin_nontemporal_load((const u32x2*)((const bf16_t*)inp2 + (size_t)row * 1024 + lane * 4 + j * 256));
                    v[rr][j] = (f32x4){DN_ALPHA * xv[0] + bflo(fv.x), DN_ALPHA * xv[1] + bfhi(fv.x), DN_ALPHA * xv[2] + bflo(fv.y), DN_ALPHA * xv[3] + bfhi(fv.y)}; }
                else if (IN_BF16 == 2) { const u32x2 hv = __builtin_nontemporal_load((const u32x2*)((const bf16_t*)inp + (size_t)(row0 + rr) * 1024 + lane * 4 + j * 256)), fv = __builtin_nontemporal_load((const u32x2*)((const bf16_t*)inp2 + (size_t)(row0 + rr) * 1024 + lane * 4 + j * 256));
                    v[rr][j] = (f32x4){DN_ALPHA * bflo(hv.x) + bflo(fv.x), DN_ALPHA * bfhi(hv.x) + bfhi(fv.x), DN_ALPHA * bflo(hv.y) + bflo(fv.y), DN_ALPHA * bfhi(hv.y) + bfhi(fv.y)}; }
                else if (IN_BF16 == 1) { const u32x2 hv = *(const u32x2*)((const bf16_t*)inp + (size_t)(row0 + rr) * 1024 + lane * 4 + j * 256); v[rr][j] = (f32x4){bflo(hv.x), bfhi(hv.x), bflo(hv.y), bfhi(hv.y)}; }
                else v[rr][j] = *(const f32x4*)((const float*)inp + (size_t)(row0 + rr) * 1024 + lane * 4 + j * 256); }
#pragma unroll
        for (int rr = 0; rr < 4; ++rr) {
#pragma unroll
            for (int j = 0; j < 4; ++j) s[rr] += (v[rr][j][0] + v[rr][j][1]) + (v[rr][j][2] + v[rr][j][3]);
#pragma unroll
            for (int o = 1; o < 64; o <<= 1) s[rr] += __shfl_xor(s[rr], o);
            const float mean = s[rr] * (1.f / 1024.f);
#pragma unroll
            for (int j = 0; j < 4; ++j) { v[rr][j] = v[rr][j] - mean; s2[rr] += (v[rr][j][0] * v[rr][j][0] + v[rr][j][1] * v[rr][j][1]) + (v[rr][j][2] * v[rr][j][2] + v[rr][j][3] * v[rr][j][3]); }
#pragma unroll
            for (int o = 1; o < 64; o <<= 1) s2[rr] += __shfl_xor(s2[rr], o);
            const float rstd = rsqrtf(s2[rr] * (1.f / 1024.f) + 1e-5f);
#pragma unroll
            for (int j = 0; j < 4; ++j) { const f32x4 y = v[rr][j] * rstd * gv[j] + bv[j];
                if (OUT_BF16) { u32x2 w; w.x = cvt_pk_bf16(y[0], y[1]); w.y = cvt_pk_bf16(y[2], y[3]); *(u32x2*)((bf16_t*)outp + (size_t)(row0 + rr) * 1024 + j * 256 + lane * 4) = w; }
                else __builtin_nontemporal_store(y, (f32x4*)((float*)outp + (size_t)(row0 + rr) * 1024 + j * 256 + lane * 4)); }
        }
    }
}

__device__ __forceinline__ void phase_ffnact(const Params& p) {
    const bf16_t* hdn = (const bf16_t*)(p.ws + OFF_HDN); bf16_t* act = (bf16_t*)(p.ws + OFF_ACT);
    const int total = 4096 * 352, nthr = gridDim.x * 512;
    for (int idx = blockIdx.x * 512 + opaque_tid(); idx < total; idx += nthr) {
        const int cgp = idx % 352, tblk = idx / 352, c0 = cgp * 8, t0 = tblk * 8, pos0 = t0 & (SEQL - 1);
        const bf16_t* hp = hdn + (size_t)t0 * 5632 + c0;
        const u32x4 zero4 = (u32x4){0u, 0u, 0u, 0u};
        u32x4 gr[10], vr[10];
#pragma unroll
        for (int rr = 0; rr < 10; ++rr) { const int pos = pos0 - 1 + rr; gr[rr] = zero4; vr[rr] = zero4;
            if (pos >= 0 && pos < SEQL) { gr[rr] = __builtin_nontemporal_load((const u32x4*)(hp + (ptrdiff_t)(rr - 1) * 5632)); vr[rr] = __builtin_nontemporal_load((const u32x4*)(hp + (ptrdiff_t)(rr - 1) * 5632 + 2816)); } }
        float wg_[3][8], wv_[3][8], bg[8], bv[8];
#pragma unroll
        for (int j = 0; j < 3; ++j) { const f32x4 a0 = *(const f32x4*)(p.fconvw + j * 5632 + c0), a1 = *(const f32x4*)(p.fconvw + j * 5632 + c0 + 4);
            const f32x4 b0 = *(const f32x4*)(p.fconvw + j * 5632 + 2816 + c0), b1 = *(const f32x4*)(p.fconvw + j * 5632 + 2816 + c0 + 4);
#pragma unroll
            for (int e = 0; e < 4; ++e) { wg_[j][e] = a0[e]; wg_[j][4 + e] = a1[e]; wv_[j][e] = b0[e]; wv_[j][4 + e] = b1[e]; } }
        { const f32x4 a0 = *(const f32x4*)(p.fconvb + c0), a1 = *(const f32x4*)(p.fconvb + c0 + 4), b0 = *(const f32x4*)(p.fconvb + 2816 + c0), b1 = *(const f32x4*)(p.fconvb + 2816 + c0 + 4);
#pragma unroll
          for (int e = 0; e < 4; ++e) { bg[e] = a0[e]; bg[4 + e] = a1[e]; bv[e] = b0[e]; bv[4 + e] = b1[e]; } }
#pragma unroll
        for (int tt = 0; tt < 8; ++tt) {
            const unsigned gpa[4] = {gr[tt].x, gr[tt].y, gr[tt].z, gr[tt].w}, gca[4] = {gr[tt + 1].x, gr[tt + 1].y, gr[tt + 1].z, gr[tt + 1].w}, gna[4] = {gr[tt + 2].x, gr[tt + 2].y, gr[tt + 2].z, gr[tt + 2].w};
            const unsigned vpa[4] = {vr[tt].x, vr[tt].y, vr[tt].z, vr[tt].w}, vca[4] = {vr[tt + 1].x, vr[tt + 1].y, vr[tt + 1].z, vr[tt + 1].w}, vna[4] = {vr[tt + 2].x, vr[tt + 2].y, vr[tt + 2].z, vr[tt + 2].w};
            float y[8];
#pragma unroll
            for (int q = 0; q < 4; ++q) {
                const float G0 = wg_[0][2 * q] * bflo(gpa[q]) + wg_[1][2 * q] * bflo(gca[q]) + wg_[2][2 * q] * bflo(gna[q]) + bg[2 * q];
                const float G1 = wg_[0][2 * q + 1] * bfhi(gpa[q]) + wg_[1][2 * q + 1] * bfhi(gca[q]) + wg_[2][2 * q + 1] * bfhi(gna[q]) + bg[2 * q + 1];
                const float V0 = wv_[0][2 * q] * bflo(vpa[q]) + wv_[1][2 * q] * bflo(vca[q]) + wv_[2][2 * q] * bflo(vna[q]) + bv[2 * q];
                const float V1 = wv_[0][2 * q + 1] * bfhi(vpa[q]) + wv_[1][2 * q + 1] * bfhi(vca[q]) + wv_[2][2 * q + 1] * bfhi(vna[q]) + bv[2 * q + 1];
                y[2 * q] = silu_f(G0) * V0; y[2 * q + 1] = silu_f(G1) * V1; }
            u32x4 w; w.x = cvt_pk_bf16(y[0], y[1]); w.y = cvt_pk_bf16(y[2], y[3]); w.z = cvt_pk_bf16(y[4], y[5]); w.w = cvt_pk_bf16(y[6], y[7]);
            *(u32x4*)(act + (size_t)(t0 + tt) * 2816 + c0) = w;
        }
    }
}

#define XB_TMO      128
#define XB_XCNT(j)  (256  + 64 * (j))
#define XB_XSUB(j)  (1280 + 64 * (j))
#define XB_XGEN(j)  (2304 + 64 * (j))
#define XB_TOP      3328
#define XB_TOPGEN   3392
#define XCD_BAR_WORDS 3456
#define XB_SPIN_CAP (1u << 20)
__device__ __forceinline__ unsigned xb_ld(unsigned* p)              { return __hip_atomic_load(p, __ATOMIC_RELAXED, __HIP_MEMORY_SCOPE_AGENT); }
__device__ __forceinline__ unsigned xb_add(unsigned* p, unsigned v) { return __hip_atomic_fetch_add(p, v, __ATOMIC_RELAXED, __HIP_MEMORY_SCOPE_AGENT); }
__device__ __forceinline__ unsigned xb_xcc_id() { return (unsigned)__builtin_amdgcn_s_getreg((3 << 11) | 20) & 0xFu; }
#define XB_SPIN(cond, bar) do { unsigned _sp = 0; while (cond) { __builtin_amdgcn_s_sleep(1); \
    if ((++_sp & 255u) == 0u) { if (xb_ld(&(bar)[XB_TMO])) break; if (_sp > XB_SPIN_CAP) { atomicAdd(&(bar)[XB_TMO], 1u); break; } } } } while (0)
struct XcdBarrier { unsigned* bar; unsigned x; volatile LAS unsigned* st; };
__device__ __forceinline__ XcdBarrier xcd_barrier_post(unsigned* bar, volatile LAS unsigned* st) {
    XcdBarrier b; b.bar = bar; b.x = xb_xcc_id(); b.st = st;
    if (threadIdx.x == 0) (void)xb_add(&bar[XB_XCNT(b.x)], 1u);
    return b;
}
__device__ __forceinline__ void xcd_barrier_complete(unsigned* bar, unsigned x, unsigned& nloc, unsigned& nx) {
    const unsigned G = gridDim.x * gridDim.y * gridDim.z;
    unsigned sum, cnt, mine, sp = 0u;
    for (;;) {
        sum = 0u; cnt = 0u; mine = 0u;
#pragma unroll
        for (unsigned j = 0; j < 16; ++j) { const unsigned c = xb_ld(&bar[XB_XCNT(j)]); sum += c; cnt += (c > 0u) ? 1u : 0u; mine = (j == x) ? c : mine; }
        if (sum == G) break;
        __builtin_amdgcn_s_sleep(1);
        if ((++sp & 255u) == 0u) { if (xb_ld(&bar[XB_TMO])) break; if (sp > XB_SPIN_CAP) { atomicAdd(&bar[XB_TMO], 1u); break; } }
    }
    nloc = mine > 0u ? mine : 1u; nx = cnt > 0u ? cnt : 1u;
}
__device__ __forceinline__ void xcd_barrier(const XcdBarrier& b) {
    asm volatile("s_waitcnt vmcnt(0)" ::: "memory");
    __syncthreads();
    if (threadIdx.x == 0) {
        unsigned* bar = b.bar;
        __builtin_amdgcn_s_waitcnt(0);
        unsigned nloc = b.st[0], nx = b.st[1];
        if (nloc == 0u) { xcd_barrier_complete(bar, b.x, nloc, nx); b.st[0] = nloc; b.st[1] = nx; }
        const unsigned old = xb_add(&bar[XB_XSUB(b.x)], 1u);
        const unsigned gen = old / nloc;
        if (old + 1u == (gen + 1u) * nloc) {
            __builtin_amdgcn_fence(__ATOMIC_RELEASE, "agent");
            asm volatile("s_waitcnt vmcnt(0)" ::: "memory");
            const unsigned og = xb_add(&bar[XB_TOP], 1u);
            const unsigned tg = og / nx;
            if (og + 1u == (tg + 1u) * nx) xb_add(&bar[XB_TOPGEN], 1u);
            else XB_SPIN(xb_ld(&bar[XB_TOPGEN]) == tg, bar);
            __builtin_amdgcn_fence(__ATOMIC_ACQUIRE, "agent");
            xb_add(&bar[XB_XGEN(b.x)], 1u);
            asm volatile("s_waitcnt vmcnt(0)" ::: "memory");
        } else {
            XB_SPIN(xb_ld(&bar[XB_XGEN(b.x)]) == gen, bar);
            __builtin_amdgcn_fence(__ATOMIC_ACQUIRE, "agent");
            asm volatile("s_waitcnt vmcnt(0)" ::: "memory");
        }
    }
    __syncthreads();
}


__device__ __forceinline__ void ffn_up(const Params& p, const int fg, LAS unsigned char* lds, pg8::StaticOrder& S) {
    pg8::Gemm g{(const bf16_t*)(p.ws + OFF_X1) + (size_t)fg * 32768 * 1024, (const bf16_t*)(p.ws + OFF_WUP), 32768, 5632, 1024};
    pg8::EpiBf16 E{(bf16_t*)(p.ws + OFF_HDN), 5632};
    S.init(g.M, g.N, gridDim.x, blockIdx.x); pg8::gemm_phase(lds, g, S, E);
}
__device__ __forceinline__ void ffn_down(const Params& p, const int fg, LAS unsigned char* lds, pg8::StaticOrder& S) {
    pg8::Gemm g{(const bf16_t*)(p.ws + OFF_ACT), (const bf16_t*)(p.ws + OFF_WDOWN), 32768, 1024, 2816};
    pg8::EpiBf16 E{(bf16_t*)(p.ws + OFF_FFNB) + (size_t)fg * 32768 * 1024, 1024};
    S.init(g.M, g.N, gridDim.x, blockIdx.x); pg8::gemm_phase(lds, g, S, E);
}
#ifndef ONLY
#define ONLY -1
#endif
#define EN(k) (ONLY < 0 || ONLY == (k))
constexpr int N_STEPS = 18;
#ifndef DUP_MASK
#define DUP_MASK 0
#endif
__device__ __forceinline__ void run_step(const Params& p, int step, unsigned char* smem) {
    LAS unsigned char* lds = (LAS unsigned char*)smem;
    pg8::StaticOrder S;
    switch (step) {
    case 0: if (EN(0)) { phase_wprep(p, smem, 0, blockIdx.x, gridDim.x); phase_xconv(p, smem); } break;
    case 1: if (EN(1)) {
        const bf16_t* xb = (const bf16_t*)(p.ws + OFF_XB); const bf16_t* wm = (const bf16_t*)(p.ws + OFF_WMAIN);
        { pg8::Gemm g{xb, wm, T_TOK, 1536, 1024}; pg8::EpiBf16 E{(bf16_t*)(p.ws + OFF_SEG), 1536};
          S.init(g.M, g.N, gridDim.x, blockIdx.x); pg8::gemm_phase(lds, g, S, E); }
        { pg8::Gemm g{xb, wm + (size_t)1536 * 1024, T_TOK, 1024, 1024}; pg8::EpiNAqk E{(bf16_t*)(p.ws + OFF_NA2)};
          S.init(g.M, g.N, gridDim.x, blockIdx.x); pg8::gemm_phase(lds, g, S, E); }
        { pg8::Gemm g{xb, wm + (size_t)2560 * 1024, T_TOK, 512, 1024}; pg8::EpiBf16 E{(bf16_t*)((unsigned char*)p.out + OOFF_Z), 512};
          S.init(g.M, g.N, gridDim.x, blockIdx.x); pg8::gemm_phase(lds, g, S, E); }
        { pg8::Gemm g{(const bf16_t*)(p.ws + OFF_WV), xb, 512, T_TOK, 1024}; pg8::EpiVT E{(bf16_t*)(p.ws + OFF_VT)};
          S.init(g.M, g.N, gridDim.x, blockIdx.x); pg8::gemm_phase(lds, g, S, E); }
    } break;
    case 2: if (EN(2)) phase_na(p, smem); break;
    case 3: if (EN(3)) phase_prep(p, 0, smem); break;
    case 4: if (EN(4)) { phase_scan(p, 0, smem);
              if (gridDim.x > 192) { if (blockIdx.x >= 192) phase_wprep(p, smem, 1, blockIdx.x - 192, gridDim.x - 192); }
              else phase_wprep(p, smem, 1, blockIdx.x, gridDim.x); } break;
    case 5: if (EN(5)) { for (int k = 0; k < 2; ++k) { if ((k == 0) != ((blockIdx.x & 1) != 0)) phase_combine(p, 0); else phase_prep(p, 1, smem); __syncthreads(); } } break;
    case 6: if (EN(4)) { phase_scan(p, 1, smem);
              if (gridDim.x > 192) { if (blockIdx.x >= 192) phase_wprep(p, smem, 2, blockIdx.x - 192, gridDim.x - 192); }
              else phase_wprep(p, smem, 2, blockIdx.x, gridDim.x); } break;
    case 7: if (EN(5)) phase_combine(p, 1); break;
    case 8: if (EN(8)) { pg8::Gemm g{(const bf16_t*)(p.ws + OFF_MIX), (const bf16_t*)(p.ws + OFF_WOUT), T_TOK, 1024, 1024};
              pg8::EpiBf16 E{(bf16_t*)(p.ws + OFF_H1), 1024};
              S.init(g.M, g.N, gridDim.x, blockIdx.x); pg8::gemm_phase(lds, g, S, E); } break;
    case 9: if (EN(9)) phase_ln<true, 3>(p.xp, p.ws + OFF_H1, p.xs, p.ws + OFF_X1, p.ln1g, p.ln1b, 0, T_TOK); break;
    case 10: if (EN(10)) ffn_up(p, 0, lds, S); break;
    case 11: case 13: case 15: if (EN(11)) phase_ffnact(p); break;
    case 12: if (EN(12)) { ffn_down(p, 0, lds, S); ffn_up(p, 1, lds, S); } break;
    case 14: case 16: if (EN(12)) {
              const int fg = (step - 12) / 2;
              for (int k = 0; k < 2; ++k) {
                  if ((k == 0) != ((blockIdx.x & 1) != 0)) phase_ln<false, 2>(p.ws + OFF_X1, p.ws + OFF_FFNB, nullptr, p.out, p.ln2g, p.ln2b, (fg - 1) * 32768, fg * 32768);
                  else { ffn_down(p, fg, lds, S); if (fg < 2) ffn_up(p, fg + 1, lds, S); }
                  __syncthreads(); } } break;
    case 17: if (EN(9)) phase_ln<false, 2>(p.ws + OFF_X1, p.ws + OFF_FFNB, nullptr, p.out, p.ln2g, p.ln2b, 65536, T_TOK); break;
    default: break;
    }
}

template <bool COOP>
__global__ void __launch_bounds__(512, 2) mega(Params p, int s0, int s1) {
    extern __shared__ __attribute__((aligned(16))) unsigned char smem[];
    XcdBarrier xb;
    if (COOP) {
        volatile LAS unsigned* st = (volatile LAS unsigned*)((LAS unsigned char*)smem + LDS_BAR_OFF);
        if (threadIdx.x == 0) { st[0] = 0u; st[1] = 0u; }
        __syncthreads();
        xb = xcd_barrier_post((unsigned*)(p.ws + OFF_BAR), st);
    }
    for (int s = s0; s < s1; ++s) {
        const int nrep = 1 + ((DUP_MASK >> s) & 1);
        for (int rep = 0; rep < nrep; ++rep) {
            int lofs = 0; asm volatile("" : "+s"(lofs));
            run_step(p, s, smem + lofs);
            if (COOP) { if (s + 1 < s1 || rep + 1 < nrep) { if (s0 < 0) cg::this_grid().sync(); else xcd_barrier(xb); } }
            else __syncthreads();
        }
    }
}

extern "C" void kernel_launch(void* const* d_in, const int* in_sizes, int n_in, void* d_out, int out_size, void* d_ws, size_t ws_size, hipStream_t stream) {
    static int grid = 0;
    if (grid == 0) {
        if (n_in != 17 || ws_size < WS_NEED || out_size != T_TOK * 1024) { fprintf(stderr, "kernel_launch: unexpected shapes (n_in %d ws %zu out %d)\n", n_in, ws_size, out_size); grid = -1; return; }
        int dev = 0, cus = 0, per_cu = 0;
        hipGetDevice(&dev); hipDeviceGetAttribute(&cus, hipDeviceAttributeMultiprocessorCount, dev);
        hipFuncSetAttribute((const void*)mega<true>, hipFuncAttributeMaxDynamicSharedMemorySize, LDS_BYTES);
        hipFuncSetAttribute((const void*)mega<false>, hipFuncAttributeMaxDynamicSharedMemorySize, LDS_BYTES);
        hipOccupancyMaxActiveBlocksPerMultiprocessor(&per_cu, (const void*)mega<true>, 512, LDS_BYTES);
        if (per_cu < 1) { fprintf(stderr, "kernel_launch: occupancy query says %d blocks/CU\n", per_cu); per_cu = 1; }
        (void)hipGetLastError();
        grid = cus;
    }
    if (grid < 0) return;
    Params p{};
    p.xp = (const float*)d_in[0]; p.xs = (const float*)d_in[1]; p.w_in = (const float*)d_in[2]; p.rpb = (const float*)d_in[3]; p.gconv = (const float*)d_in[4];
    p.a_log = (const float*)d_in[5]; p.dt_bias = (const float*)d_in[6]; p.gnorm = (const float*)d_in[7]; p.w_out = (const float*)d_in[8]; p.ln1g = (const float*)d_in[9];
    p.ln1b = (const float*)d_in[10]; p.w_up = (const float*)d_in[11]; p.fconvw = (const float*)d_in[12]; p.fconvb = (const float*)d_in[13]; p.w_down = (const float*)d_in[14];
    p.ln2g = (const float*)d_in[15]; p.ln2b = (const float*)d_in[16]; p.out = (float*)d_out; p.ws = (unsigned char*)d_ws;
#if ONE_LAUNCH
    if (hipMemsetAsync((unsigned char*)d_ws + OFF_BAR, 0, XCD_BAR_WORDS * sizeof(unsigned), stream) != hipSuccess) { fprintf(stderr, "kernel_launch: memset of barrier words failed\n"); return; }
    int s0 = 0, s1 = N_STEPS;
    void* args[] = {&p, &s0, &s1};
    hipError_t e = hipLaunchCooperativeKernel((const void*)mega<true>, dim3(grid), dim3(512), args, LDS_BYTES, stream);
    if (e != hipSuccess) fprintf(stderr, "cooperative launch failed: %s (grid %d)\n", hipGetErrorString(e), grid);
#else
    for (int s = 0; s < N_STEPS; ++s) hipLaunchKernelGGL(mega<false>, dim3(grid), dim3(512), LDS_BYTES, stream, p, s, s + 1);
#endif
}
```

```cpp
#include <hip/hip_runtime.h>
#include <hip/hip_cooperative_groups.h>
#include <cstdio>
namespace cg = cooperative_groups;

#define LAS __attribute__((address_space(3)))
typedef unsigned short bf16_t;
typedef short bf16x8 __attribute__((ext_vector_type(8)));
typedef float f32x4 __attribute__((ext_vector_type(4)));
typedef unsigned u32x4 __attribute__((ext_vector_type(4)));
typedef unsigned u32x2 __attribute__((ext_vector_type(2)));

#ifndef ONE_LAUNCH
#define ONE_LAUNCH 1
#endif

constexpr int T_TOK = 98304, T_PROMPT = 32768, SEQL = 2048;
constexpr size_t MiB = (size_t)1 << 20;
constexpr size_t OFF_WMAIN = 0, OFF_WV = 6 * MiB, OFF_WG = 7 * MiB, OFF_WOUT = 8 * MiB, OFF_WUP = 10 * MiB, OFF_WDOWN = 21 * MiB, OFF_CD = 27 * MiB,
                 OFF_XB = 28 * MiB, OFF_MIX = 28 * MiB, OFF_SEG = 220 * MiB, OFF_NA2 = 508 * MiB, OFF_VT = 700 * MiB, OFF_PREP = 508 * MiB, OFF_H1 = 220 * MiB,
                 OFF_X1 = 604 * MiB, OFF_FFNB = 796 * MiB, OFF_HDN = 28 * MiB, OFF_ACT = 380 * MiB, WS_NEED = 1024 * MiB;
constexpr size_t SEG_ELEMS = (size_t)T_TOK * 512;
constexpr size_t OOFF_O = 0, OOFF_GATES = 192 * MiB, OOFF_Z = 198 * MiB;
constexpr int PREP_ITEM = 73728;
constexpr int PI_W = 0, PI_QD = 16384, PI_ATTN = 32768, PI_KDT = 40960, PI_UT = 57344;
constexpr int LDS_BAR_OFF = 155648, LDS_BYTES = LDS_BAR_OFF + 16;
constexpr size_t OFF_BAR = 27 * MiB + 512 * 1024;
constexpr float DN_ALPHA = 1.189207115002721f;

struct Params {
    const float* xp; const float* xs; const float* w_in; const float* rpb; const float* gconv; const float* a_log; const float* dt_bias; const float* gnorm;
    const float* w_out; const float* ln1g; const float* ln1b; const float* w_up; const float* fconvw; const float* fconvb; const float* w_down;
    const float* ln2g; const float* ln2b; float* out; unsigned char* ws;
};

__device__ __forceinline__ int opaque_tid() { int t = threadIdx.x; asm volatile("" : "+v"(t)); return t; }
typedef float f32x2_t __attribute__((ext_vector_type(2)));
typedef __bf16 bf16x2_t __attribute__((ext_vector_type(2)));
__device__ __forceinline__ unsigned cvt_pk_bf16(float lo, float hi) { const f32x2_t v = {lo, hi}; union { bf16x2_t b; unsigned u; } c; c.b = __builtin_convertvector(v, bf16x2_t); return c.u; }
__device__ __forceinline__ float bflo(unsigned u) { return __uint_as_float(u << 16); }
__device__ __forceinline__ float bfhi(unsigned u) { return __uint_as_float(u & 0xffff0000u); }
__device__ __forceinline__ float bf2f(bf16_t b) { return __uint_as_float(((unsigned)b) << 16); }
__device__ __forceinline__ bf16_t f2bf(float f) { return (bf16_t)(cvt_pk_bf16(f, 0.f) & 0xffffu); }
__device__ __forceinline__ float silu_f(float x) { return x * __builtin_amdgcn_rcpf(1.f + __expf(-x)); }
__device__ __forceinline__ float sigmoid_f(float x) { return __builtin_amdgcn_rcpf(1.f + __expf(-x)); }
__device__ __forceinline__ const float* xrow(const Params& p, int row) { return row < T_PROMPT ? p.xp + (size_t)row * 1024 : p.xs + (size_t)(row - T_PROMPT) * 1024; }
__device__ __forceinline__ bf16x8 as_bf16x8(u32x4 v) { union { u32x4 u; bf16x8 b; } c; c.u = v; return c.b; }
__device__ __forceinline__ int perm_k(int c) { return (c & ~31) | (((c >> 2) & 3) << 3) | (((c >> 4) & 1) << 2) | (c & 3); }

namespace pg8 {
constexpr int BM = 256, BK = 64, HALF = 128, HTB = HALF * BK * 2, STAGE_BYTES = 8 * HTB, NXCD = 8, WGM = 8;
__host__ __device__ __forceinline__ int lds_byte(int r, int c) { const int st = (r >> 4) * 2 + (c >> 5), rr = r & 15, cc = c & 31, ob = rr * 64 + cc * 2; return st * 1024 + (ob ^ (((ob >> 9) & 1) << 5)); }
__host__ __device__ __forceinline__ void stage_rc(int b, int& R, int& C) { const int st = b / 1024, sb = b % 1024, swz = sb ^ (((sb >> 9) & 1) << 5); R = (st >> 1) * 16 + swz / 64; C = (st & 1) * 32 + (swz % 64) / 2; }
__host__ __device__ __forceinline__ int perm32(int rho) { const int n = rho >> 4, i = rho & 15; return 8 * (i >> 2) + 4 * n + (i & 3); }
struct Unit { int pm, pn; };
struct Gemm { const bf16_t* A; const bf16_t* Bt; int M, N, K; };
struct StaticOrder {
    int nM, nN, nwg, G, c;
    __device__ void init(int M, int N, int G_, int c_) { nM = M / BM; nN = N / BM; nwg = nM * nN; G = G_; c = c_; }
    __device__ bool next(int i, Unit& u) const {
        const long L = (long)i * G + c; if (L >= nwg) return false;
        int wgid = (int)L; { const int q = nwg / NXCD, r = nwg % NXCD, xcd = wgid % NXCD, off = wgid / NXCD; wgid = (xcd < r ? xcd * (q + 1) : r * (q + 1) + (xcd - r) * q) + off; }
        const int nig = WGM * nN, gid = wgid / nig, fm = gid * WGM, gsz = (nM - fm) < WGM ? (nM - fm) : WGM;
        u.pm = fm + ((wgid % nig) % gsz); u.pn = (wgid % nig) / gsz; return true;
    }
};

template <class Epi>
__device__ __forceinline__ void gemm_phase(LAS unsigned char* lds, const Gemm g, const StaticOrder& S, const Epi& E) {
    const int tid = opaque_tid(), wid = __builtin_amdgcn_readfirstlane(tid >> 6), lane = tid & 63, wr = wid >> 2, wc = wid & 3, fr = lane & 15, fq = lane >> 4;
    const int K = g.K, nt = K / BK;
    unsigned voffA[2], voffB[2];
#pragma unroll
    for (int i = 0; i < 2; ++i) { int R, C; stage_rc(tid * 16 + i * 8192, R, C); const int Rb = Epi::PERM ? ((R & ~31) + perm32(R & 31)) : R;
        voffA[i] = (unsigned)(R * K + C) * 2u; voffB[i] = (unsigned)(Rb * K + C) * 2u; }
    const size_t kstep = (size_t)(BK * 2);
    const size_t hstep = (size_t)HALF * K * 2;
    const size_t tstep = 2 * hstep;
    const unsigned ldsw = (unsigned)wid * 1024u;
    const int aoff = lds_byte(wr * 64 + fr, fq * 8), boff = lds_byte(wc * 32 + fr, fq * 8);
#define PG8_SA(b, h) (((b) * 2 + (h)) * HTB)
#define PG8_SB(b, h) ((4 + (b) * 2 + (h)) * HTB)
#define PG8_STAGE(bufoff, gbase, voff) do { _Pragma("unroll") for (int _i = 0; _i < 2; ++_i) \
        __builtin_amdgcn_global_load_lds((const unsigned*)((const char*)(gbase) + (voff)[_i]), (LAS unsigned*)(lds + (bufoff) + ldsw + _i * 8192), 16, 0, 0); } while (0)
#define PG8_LDA(dst, b, h) do { _Pragma("unroll") for (int m = 0; m < 4; ++m) _Pragma("unroll") for (int k = 0; k < 2; ++k) dst[m][k] = *(const LAS bf16x8*)(lds + PG8_SA(b, h) + aoff + m * 2048 + k * 1024); } while (0)
#define PG8_LDB(dst, b, h) do { _Pragma("unroll") for (int n = 0; n < 2; ++n) _Pragma("unroll") for (int k = 0; k < 2; ++k) dst[n][k] = *(const LAS bf16x8*)(lds + PG8_SB(b, h) + boff + n * 2048 + k * 1024); } while (0)
#define PG8_MMA(ai, bj, At, Bt) do { __builtin_amdgcn_s_setprio(1); _Pragma("unroll") for (int m = 0; m < 4; ++m) _Pragma("unroll") for (int n = 0; n < 2; ++n) _Pragma("unroll") for (int k = 0; k < 2; ++k) \
        acc[ai][bj][m][n] = __builtin_amdgcn_mfma_f32_16x16x32_bf16(Bt[n][k], At[m][k], acc[ai][bj][m][n], 0, 0, 0); __builtin_amdgcn_s_setprio(0); } while (0)
#define PG8_WAIT_V(n) asm volatile("s_waitcnt vmcnt(" #n ")" ::: "memory")
#define PG8_WAIT_L(n) asm volatile("s_waitcnt lgkmcnt(" #n ")" ::: "memory")
#define PG8_BAR __builtin_amdgcn_s_barrier()
#define PG8_SCHED __builtin_amdgcn_sched_barrier(0)
    Unit cur, nxt; int ui = 0;
    if (!S.next(0, cur)) return;
    f32x4 acc[2][2][4][2];
#pragma unroll
    for (int a = 0; a < 2; ++a)
#pragma unroll
        for (int b = 0; b < 2; ++b)
#pragma unroll
            for (int m = 0; m < 4; ++m)
#pragma unroll
                for (int n = 0; n < 2; ++n) acc[a][b][m][n] = (f32x4){0.f, 0.f, 0.f, 0.f};
    bf16x8 At[4][2], B0[2][2], B1[2][2];
    const char* cA = (const char*)g.A + (size_t)cur.pm * tstep; const char* cB = (const char*)g.Bt + (size_t)cur.pn * tstep;
    PG8_STAGE(PG8_SB(0, 0), cB, voffB); PG8_STAGE(PG8_SA(0, 0), cA, voffA); PG8_STAGE(PG8_SB(0, 1), cB + hstep, voffB); PG8_STAGE(PG8_SA(0, 1), cA + hstep, voffA);
    if (wr == 1) PG8_BAR;
    PG8_WAIT_V(4); PG8_BAR;
    PG8_STAGE(PG8_SB(1, 0), cB + kstep, voffB); PG8_STAGE(PG8_SA(1, 0), cA + kstep, voffA); PG8_STAGE(PG8_SB(1, 1), cB + hstep + kstep, voffB);
    PG8_WAIT_V(6); PG8_BAR;
    for (;;) {
        const bool has_next = S.next(ui + 1, nxt);
        const char* nA = has_next ? (const char*)g.A + (size_t)nxt.pm * tstep : cA; const char* nB = has_next ? (const char*)g.Bt + (size_t)nxt.pn * tstep : cB;
        for (int t = 0; t < nt; t += 2) {
            const bool last = (t == nt - 2);
            const char* a1 = cA + (size_t)(t + 1) * kstep;
            const char* a2 = last ? nA : cA + (size_t)(t + 2) * kstep; const char* b2 = last ? nB : cB + (size_t)(t + 2) * kstep;
            const char* a3 = a2 + kstep; const char* b3 = b2 + kstep;
            PG8_LDB(B0, 0, 0); PG8_SCHED; PG8_LDA(At, 0, 0); PG8_STAGE(PG8_SA(1, 1), a1 + hstep, voffA);
            PG8_WAIT_L(8); PG8_BAR; PG8_WAIT_L(0); PG8_MMA(0, 0, At, B0); PG8_BAR; PG8_SCHED;
            PG8_LDB(B1, 0, 1); PG8_STAGE(PG8_SB(0, 0), b2, voffB);
            PG8_BAR; PG8_WAIT_L(0); PG8_MMA(0, 1, At, B1); PG8_BAR;
            PG8_LDA(At, 0, 1); PG8_STAGE(PG8_SA(0, 0), a2, voffA);
            PG8_BAR; PG8_WAIT_L(0); PG8_MMA(1, 0, At, B0); PG8_BAR; PG8_SCHED;
            PG8_STAGE(PG8_SB(0, 1), b2 + hstep, voffB);
            PG8_WAIT_V(6); PG8_BAR; PG8_MMA(1, 1, At, B1); PG8_BAR;
            PG8_LDB(B0, 1, 0); PG8_SCHED; PG8_LDA(At, 1, 0); PG8_STAGE(PG8_SA(0, 1), a2 + hstep, voffA);
            PG8_WAIT_L(8); PG8_BAR; PG8_WAIT_L(0); PG8_MMA(0, 0, At, B0); PG8_BAR; PG8_SCHED;
            PG8_LDB(B1, 1, 1); PG8_STAGE(PG8_SB(1, 0), b3, voffB);
            PG8_BAR; PG8_WAIT_L(0); PG8_MMA(0, 1, At, B1); PG8_BAR;
            PG8_LDA(At, 1, 1); PG8_STAGE(PG8_SA(1, 0), a3, voffA);
            PG8_BAR; PG8_WAIT_L(0); PG8_MMA(1, 0, At, B0); PG8_BAR; PG8_SCHED;
            PG8_STAGE(PG8_SB(1, 1), b3 + hstep, voffB);
            PG8_WAIT_V(6); PG8_BAR; PG8_MMA(1, 1, At, B1); PG8_BAR;
        }
        E(acc, cur, wr, wc, fr, fq);
        if (!has_next) break;
#pragma unroll
        for (int a = 0; a < 2; ++a)
#pragma unroll
            for (int b = 0; b < 2; ++b)
#pragma unroll
                for (int m = 0; m < 4; ++m)
#pragma unroll
                    for (int n = 0; n < 2; ++n) acc[a][b][m][n] = (f32x4){0.f, 0.f, 0.f, 0.f};
        cur = nxt; cA = nA; cB = nB; ++ui;
    }
    PG8_WAIT_V(0);
    if (wr == 0) PG8_BAR;
    PG8_BAR;
#undef PG8_SA
#undef PG8_SB
#undef PG8_STAGE
#undef PG8_LDA
#undef PG8_LDB
#undef PG8_MMA
#undef PG8_WAIT_V
#undef PG8_WAIT_L
#undef PG8_BAR
#undef PG8_SCHED
}

struct EpiBf16 {
    static constexpr bool PERM = true;
    bf16_t* O; int ldc;
    __device__ __forceinline__ void operator()(const f32x4 (&acc)[2][2][4][2], const Unit& u, int wr, int wc, int fr, int fq) const {
        const int row0 = u.pm * BM + wr * 64 + fr, col0 = u.pn * BM + wc * 32 + 8 * fq; bf16_t* base = O;
#pragma unroll
        for (int ai = 0; ai < 2; ++ai)
#pragma unroll
            for (int m = 0; m < 4; ++m) { bf16_t* rowp = base + (size_t)(row0 + ai * HALF + m * 16) * ldc + col0;
#pragma unroll
                for (int bj = 0; bj < 2; ++bj) { const f32x4 v0 = acc[ai][bj][m][0], v1 = acc[ai][bj][m][1];
                    u32x4 w; w.x = cvt_pk_bf16(v0[0], v0[1]); w.y = cvt_pk_bf16(v0[2], v0[3]); w.z = cvt_pk_bf16(v1[0], v1[1]); w.w = cvt_pk_bf16(v1[2], v1[3]);
                    *(u32x4*)(rowp + bj * HALF) = w; } }
    }
};
struct EpiNAqk {
    static constexpr bool PERM = true;
    bf16_t* O;
    __device__ __forceinline__ void operator()(const f32x4 (&acc)[2][2][4][2], const Unit& u, int wr, int wc, int fr, int fq) const {
        const int row0 = u.pm * BM + wr * 64 + fr;
#pragma unroll
        for (int ai = 0; ai < 2; ++ai)
#pragma unroll
            for (int m = 0; m < 4; ++m) { const int tok = row0 + ai * HALF + m * 16;
#pragma unroll
                for (int bj = 0; bj < 2; ++bj) { const int hh = u.pn * 4 + bj * 2 + (wc >> 1);
                    bf16_t* dst = O + (size_t)hh * ((size_t)T_TOK * 64) + (size_t)(tok >> 3) * 512 + (wc & 1) * 256 + (tok & 7) * 32 + fq * 8;
                    const f32x4 v0 = acc[ai][bj][m][0], v1 = acc[ai][bj][m][1];
                    u32x4 w; w.x = cvt_pk_bf16(v0[0], v0[1]); w.y = cvt_pk_bf16(v0[2], v0[3]); w.z = cvt_pk_bf16(v1[0], v1[1]); w.w = cvt_pk_bf16(v1[2], v1[3]);
                    *(u32x4*)dst = w; } }
    }
};
struct EpiVT {
    static constexpr bool PERM = true;
    bf16_t* O;
    __device__ __forceinline__ void operator()(const f32x4 (&acc)[2][2][4][2], const Unit& u, int wr, int wc, int fr, int fq) const {
        const int row0 = u.pm * BM + wr * 64 + fr, col0 = u.pn * BM + wc * 32 + 8 * fq;
#pragma unroll
        for (int ai = 0; ai < 2; ++ai)
#pragma unroll
            for (int m = 0; m < 4; ++m) { const int f = row0 + ai * HALF + m * 16;
                bf16_t* fb = O + (size_t)(f >> 6) * ((size_t)T_TOK * 64) + (f & 63) * 4;
#pragma unroll
                for (int bj = 0; bj < 2; ++bj)
#pragma unroll
                    for (int n = 0; n < 2; ++n) { const f32x4 v = acc[ai][bj][m][n];
                        u32x2 w; w.x = cvt_pk_bf16(v[0], v[1]); w.y = cvt_pk_bf16(v[2], v[3]);
                        *(u32x2*)(fb + (size_t)(((col0 + bj * HALF) >> 2) + n) * 256) = w; } }
    }
};
template <bool RES_BF16> struct EpiRes {
    static constexpr bool PERM = false;
    float* C; const void* res0; const void* res1; int split_row; float alpha;
    __device__ __forceinline__ void operator()(const f32x4 (&acc)[2][2][4][2], const Unit& u, int wr, int wc, int fr, int fq) const {
        const int row0 = u.pm * BM + wr * 64 + fr, col0 = u.pn * BM + wc * 32 + 4 * fq;
#pragma unroll
        for (int ai = 0; ai < 2; ++ai)
#pragma unroll
            for (int m = 0; m < 4; ++m) { const int row = row0 + ai * HALF + m * 16; float* rowp = C + (size_t)row * 1024 + col0;
                const size_t roff = (row < split_row) ? (size_t)row * 1024 : (size_t)(row - split_row) * 1024; const void* rb = (row < split_row) ? res0 : res1;
#pragma unroll
                for (int bj = 0; bj < 2; ++bj)
#pragma unroll
                    for (int n = 0; n < 2; ++n) { const int co = bj * HALF + n * 16; f32x4 r;
                        if (RES_BF16) { const u32x2 rv = *(const u32x2*)((const bf16_t*)rb + roff + col0 + co); r = (f32x4){bflo(rv.x), bfhi(rv.x), bflo(rv.y), bfhi(rv.y)}; }
                        else r = *(const f32x4*)((const float*)rb + roff + col0 + co);
                        *(f32x4*)(rowp + co) = acc[ai][bj][m][n] + alpha * r; } }
    }
};
struct EpiResToBf16 {
    static constexpr bool PERM = true;
    bf16_t* H; const float* x0; const float* x1; int split_row; float alpha;
    __device__ __forceinline__ void operator()(const f32x4 (&acc)[2][2][4][2], const Unit& u, int wr, int wc, int fr, int fq) const {
        const int row0 = u.pm * BM + wr * 64 + fr, col0 = u.pn * BM + wc * 32 + 8 * fq;
#pragma unroll
        for (int ai = 0; ai < 2; ++ai)
#pragma unroll
            for (int m = 0; m < 4; ++m) { const int row = row0 + ai * HALF + m * 16;
                const float* xr = ((row < split_row) ? x0 + (size_t)row * 1024 : x1 + (size_t)(row - split_row) * 1024) + col0;
#pragma unroll
                for (int bj = 0; bj < 2; ++bj) { const f32x4 xa = *(const f32x4*)(xr + bj * HALF), xb = *(const f32x4*)(xr + bj * HALF + 4);
                    const f32x4 v0 = acc[ai][bj][m][0] + alpha * xa, v1 = acc[ai][bj][m][1] + alpha * xb;
                    u32x4 w; w.x = cvt_pk_bf16(v0[0], v0[1]); w.y = cvt_pk_bf16(v0[2], v0[3]); w.z = cvt_pk_bf16(v1[0], v1[1]); w.w = cvt_pk_bf16(v1[2], v1[3]);
                    *(u32x4*)(H + (size_t)row * 1024 + col0 + bj * HALF) = w; } }
    }
};
}

template <int MODE>
__device__ __forceinline__ void wprep_mat(const Params& p, float* tile, const float* src, const int N, const int ntn, const int njobs, const int bid0, const int nb) {
    const int tid = opaque_tid();
    for (int job = bid0; job < njobs; job += nb) {
        const int kt = job / ntn, nt = job % ntn, k0 = kt * 64, n0 = nt * 64;
        { const int kr = tid >> 4, nc = (tid & 15) * 4;
#pragma unroll
          for (int ps = 0; ps < 2; ++ps) { const int k = k0 + kr + ps * 32, n = n0 + nc; f32x4 v = (f32x4){0.f, 0.f, 0.f, 0.f};
              if (n < N) v = *(const f32x4*)(src + (size_t)k * N + n);
              float* tp = tile + (kr + ps * 32) * 65 + nc; tp[0] = v[0]; tp[1] = v[1]; tp[2] = v[2]; tp[3] = v[3]; } }
        __syncthreads();
        { const int nr = tid >> 3, kc = (tid & 7) * 8, n = n0 + nr;
          if (n < N) { float v[8];
#pragma unroll
              for (int e = 0; e < 8; ++e) v[e] = tile[(kc + e) * 65 + nr];
              u32x4 w; w.x = cvt_pk_bf16(v[0], v[1]); w.y = cvt_pk_bf16(v[2], v[3]); w.z = cvt_pk_bf16(v[4], v[5]); w.w = cvt_pk_bf16(v[6], v[7]);
              size_t doff;
              if (MODE == 0) {
                  if (n < 512) doff = OFF_WMAIN + (size_t)(1536 + n) * 2048;
                  else if (n < 1024) doff = OFF_WMAIN + (size_t)(2048 + n - 512) * 2048;
                  else if (n < 1536) doff = OFF_WV + (size_t)(n - 1024) * 2048;
                  else if (n < 2048) doff = OFF_WMAIN + (size_t)(n - 1536) * 2048;
                  else if (n < 2560) doff = OFF_WMAIN + (size_t)(512 + n - 2048) * 2048;
                  else if (n < 3072) doff = OFF_WMAIN + (size_t)(1024 + n - 2560) * 2048;
                  else if (n < 3584) doff = OFF_WMAIN + (size_t)(2560 + n - 3072) * 2048;
                  else doff = OFF_WG + (size_t)(n - 3584) * 2048;
              } else if (MODE == 1) doff = OFF_WOUT + (size_t)n * 2048;
              else if (MODE == 2) doff = OFF_WUP + (size_t)n * 2048;
              else doff = OFF_WDOWN + (size_t)n * 5632;
              *(u32x4*)(p.ws + doff + (size_t)(k0 + kc) * 2) = w; } }
        __syncthreads();
    }
}
__device__ __forceinline__ void phase_wprep(const Params& p, unsigned char* smem, const int part, const int bid0, const int nb) {
    float* tile = (float*)smem;
    if (part == 0) wprep_mat<0>(p, tile, p.w_in, 3600, 57, 912, bid0, nb);
    else if (part == 1) { wprep_mat<1>(p, tile, p.w_out, 1024, 16, 256, bid0, nb); wprep_mat<3>(p, tile, p.w_down, 1024, 16, 704, bid0, nb); }
    else wprep_mat<2>(p, tile, p.w_up, 5632, 88, 1408, bid0, nb);
}

__device__ __forceinline__ void phase_xconv(const Params& p, unsigned char* smem) {
    bf16_t* wg = (bf16_t*)smem; bf16_t* tile = (bf16_t*)(smem + 33024); float* red = (float*)(smem + 66048);
    const int tid = opaque_tid(), wid = tid >> 6, lane = tid & 63, c = lane & 15, g = lane >> 4;
    for (int idx = tid; idx < 16384; idx += 512) { const int k = idx >> 4, n = idx & 15; wg[n * 1032 + k] = f2bf(p.w_in[(size_t)k * 3600 + 3584 + n]); }
    bf16_t* xb = (bf16_t*)(p.ws + OFF_XB);
    float* gates = (float*)((unsigned char*)p.out + OOFF_GATES);
    const int row = tid >> 5, seg = tid & 31;
    f32x4 cur[8];
    int grp = blockIdx.x;
    if (grp < T_TOK / 16) { const float* src = xrow(p, grp * 16 + row) + 4 * seg;
#pragma unroll
        for (int j = 0; j < 8; ++j) cur[j] = __builtin_nontemporal_load((const f32x4*)(src + 128 * j)); }
    __syncthreads();
    for (; grp < T_TOK / 16; grp += gridDim.x) {
        bf16_t* dst = xb + (size_t)(grp * 16 + row) * 1024 + 4 * seg;
#pragma unroll
        for (int j = 0; j < 8; ++j) { u32x2 w; w.x = cvt_pk_bf16(cur[j][0], cur[j][1]); w.y = cvt_pk_bf16(cur[j][2], cur[j][3]);
            *(u32x2*)(dst + 128 * j) = w; *(u32x2*)(tile + row * 1032 + 128 * j + 4 * seg) = w; }
        const int nxt = grp + gridDim.x;
        if (nxt < T_TOK / 16) { const float* src = xrow(p, nxt * 16 + row) + 4 * seg;
#pragma unroll
            for (int j = 0; j < 8; ++j) cur[j] = __builtin_nontemporal_load((const f32x4*)(src + 128 * j)); }
        __syncthreads();
        { f32x4 acc = (f32x4){0.f, 0.f, 0.f, 0.f};
#pragma unroll
          for (int ks = 0; ks < 4; ++ks) { const bf16x8 af = *(const bf16x8*)(tile + c * 1032 + 128 * wid + 32 * ks + 8 * g), bfr = *(const bf16x8*)(wg + c * 1032 + 128 * wid + 32 * ks + 8 * g);
              acc = __builtin_amdgcn_mfma_f32_16x16x32_bf16(af, bfr, acc, 0, 0, 0); }
#pragma unroll
          for (int i = 0; i < 4; ++i) red[wid * 256 + (4 * g + i) * 16 + c] = acc[i]; }
        __syncthreads();
        if (tid < 256) { float sum = 0.f;
#pragma unroll
            for (int w = 0; w < 8; ++w) sum += red[w * 256 + tid];
            gates[(size_t)grp * 256 + tid] = sum; }
        __syncthreads();
    }
}

__device__ __forceinline__ void phase_na(const Params& p, unsigned char* smem) {
    float* rpbs = (float*)smem;
    const int tid = opaque_tid(), wid = tid >> 6, lane = tid & 63, c = lane & 15, g = lane >> 4;
    for (int i = tid; i < 8 * 15 * 31; i += 512) rpbs[i] = p.rpb[i];
    __syncthreads();
    const bf16_t* QK = (const bf16_t*)(p.ws + OFF_NA2);
    const bf16_t* VT = (const bf16_t*)(p.ws + OFF_VT);
    bf16_t* mix = (bf16_t*)(p.ws + OFF_MIX);
    const bool xcd_order = (gridDim.x == 256);
    const int nsteps = xcd_order ? 12 : (3072 + (int)gridDim.x - 1) / (int)gridDim.x;
    for (int step = 0; step < nsteps; ++step) {
        int plane, rp2;
        if (xcd_order) { const int xcd = blockIdx.x & 7, idx = blockIdx.x >> 3; plane = xcd * 48 + step * 4 + (idx >> 3); rp2 = idx & 7; }
        else { const int sid = step * (int)gridDim.x + (int)blockIdx.x; if (sid >= 3072) break; plane = sid >> 3; rp2 = sid & 7; }
        const int b = plane >> 3, h = plane & 7;
        const int r0 = 2 * (2 * rp2 + (wid >> 2)), cb = wid & 3;
        const int rsA = min(max(r0 - 4, 0), 24), rsB = min(max(r0 - 3, 0), 24), dB = rsB - rsA;
        const int kc0 = min(max(cb * 16 - 8, 0), 32);
        const int qc = cb * 16 + c, tokqA = b * SEQL + r0 * 64 + qc, tokqB = tokqA + 64;
        bf16x8 qA[2], qB[2];
#pragma unroll
        for (int ks = 0; ks < 2; ++ks) {
            qA[ks] = *(const bf16x8*)(QK + (size_t)h * ((size_t)T_TOK * 64) + (size_t)(tokqA >> 3) * 512 + ks * 256 + (tokqA & 7) * 32 + 8 * g);
            qB[ks] = *(const bf16x8*)(QK + (size_t)h * ((size_t)T_TOK * 64) + (size_t)(tokqB >> 3) * 512 + ks * 256 + (tokqB & 7) * 32 + 8 * g); }
        const int th = c + (cb == 0 ? -8 : (cb == 3 ? 8 : 0));
        bool use0[4]; int dcs[4];
#pragma unroll
        for (int i = 0; i < 4; ++i) { use0[i] = (4 * g + i) >= th; const int kc = kc0 + 4 * g + i + (use0[i] ? 0 : 16); dcs[i] = kc - qc + 15; }
        float sA[8][4], tB[9][4];
        {
            const bf16_t* kplane = QK + (size_t)(8 + h) * ((size_t)T_TOK * 64) + (c & 7) * 32 + 8 * g;
            const size_t tok0 = (size_t)b * SEQL + kc0 + c;
#pragma unroll
            for (int jj = 0; jj < 9; ++jj) {
                const int row = min(rsA + jj, 31);
                const bf16_t* kb = kplane + ((tok0 + row * 64) >> 3) * 512;
                bf16x8 kf[2][2];
#pragma unroll
                for (int kt = 0; kt < 2; ++kt)
#pragma unroll
                    for (int ks = 0; ks < 2; ++ks) kf[kt][ks] = *(const bf16x8*)(kb + kt * 2 * 512 + ks * 256);
                f32x4 aA[2], aB[2];
#pragma unroll
                for (int kt = 0; kt < 2; ++kt) {
                    aA[kt] = (f32x4){0.f, 0.f, 0.f, 0.f}; aB[kt] = (f32x4){0.f, 0.f, 0.f, 0.f};
#pragma unroll
                    for (int ks = 0; ks < 2; ++ks) { if (jj < 8) aA[kt] = __builtin_amdgcn_mfma_f32_16x16x32_bf16(kf[kt][ks], qA[ks], aA[kt], 0, 0, 0);
                        aB[kt] = __builtin_amdgcn_mfma_f32_16x16x32_bf16(kf[kt][ks], qB[ks], aB[kt], 0, 0, 0); } }
#pragma unroll
                for (int i = 0; i < 4; ++i) { if (jj < 8) sA[jj][i] = use0[i] ? aA[0][i] : aA[1][i]; tB[jj][i] = use0[i] ? aB[0][i] : aB[1][i]; }
            }
        }
        float sB[8][4];
#pragma unroll
        for (int j = 0; j < 8; ++j) {
            const float* browA = rpbs + (h * 15 + (rsA + j - r0 + 7)) * 31;
            const float* browB = rpbs + (h * 15 + (rsB + j - r0 + 6)) * 31;
#pragma unroll
            for (int i = 0; i < 4; ++i) { sA[j][i] = sA[j][i] * 0.125f + browA[dcs[i]]; sB[j][i] = (dB ? tB[j + 1][i] : tB[j][i]) * 0.125f + browB[dcs[i]]; }
        }
        float mxA = -1e30f, mxB = -1e30f;
#pragma unroll
        for (int j = 0; j < 8; ++j)
#pragma unroll
            for (int i = 0; i < 4; ++i) { mxA = fmaxf(mxA, sA[j][i]); mxB = fmaxf(mxB, sB[j][i]); }
        mxA = fmaxf(mxA, __shfl_xor(mxA, 16)); mxA = fmaxf(mxA, __shfl_xor(mxA, 32));
        mxB = fmaxf(mxB, __shfl_xor(mxB, 16)); mxB = fmaxf(mxB, __shfl_xor(mxB, 32));
        float sumA = 0.f, sumB = 0.f;
        unsigned pA[8][2], pB[8][2];
#pragma unroll
        for (int j = 0; j < 8; ++j) { float eA[4], eB[4];
#pragma unroll
            for (int i = 0; i < 4; ++i) { eA[i] = __expf(sA[j][i] - mxA); sumA += eA[i]; eB[i] = __expf(sB[j][i] - mxB); sumB += eB[i]; }
            pA[j][0] = cvt_pk_bf16(eA[0], eA[1]); pA[j][1] = cvt_pk_bf16(eA[2], eA[3]); pB[j][0] = cvt_pk_bf16(eB[0], eB[1]); pB[j][1] = cvt_pk_bf16(eB[2], eB[3]); }
        sumA += __shfl_xor(sumA, 16); sumA += __shfl_xor(sumA, 32);
        sumB += __shfl_xor(sumB, 16); sumB += __shfl_xor(sumB, 32);
        f32x4 oA[4], oB[4];
#pragma unroll
        for (int mt = 0; mt < 4; ++mt) { oA[mt] = (f32x4){0.f, 0.f, 0.f, 0.f}; oB[mt] = (f32x4){0.f, 0.f, 0.f, 0.f}; }
        {
            const bf16_t* vplane = VT + (size_t)h * ((size_t)T_TOK * 64) + c * 4;
            const size_t tk0 = (size_t)b * SEQL + kc0 + 4 * g;
#pragma unroll
            for (int jj = 0; jj < 9; ++jj) {
                const int row = min(rsA + jj, 31);
                const bf16_t* vb = vplane + ((tk0 + row * 64) >> 2) * 256;
                u32x2 vlo[4], vhi[4];
#pragma unroll
                for (int mt = 0; mt < 4; ++mt) { vlo[mt] = *(const u32x2*)(vb + mt * 64); vhi[mt] = *(const u32x2*)(vb + mt * 64 + 1024); }
                unsigned b01, b23;
                if (jj == 0) { b01 = dB ? 0u : pB[0][0]; b23 = dB ? 0u : pB[0][1]; }
                else if (jj == 8) { b01 = dB ? pB[7][0] : 0u; b23 = dB ? pB[7][1] : 0u; }
                else { b01 = dB ? pB[jj - 1][0] : pB[jj][0]; b23 = dB ? pB[jj - 1][1] : pB[jj][1]; }
                u32x4 pwB;
                pwB.x = (use0[0] ? (b01 & 0xffffu) : 0u) | (use0[1] ? (b01 & 0xffff0000u) : 0u);
                pwB.y = (use0[2] ? (b23 & 0xffffu) : 0u) | (use0[3] ? (b23 & 0xffff0000u) : 0u);
                pwB.z = (use0[0] ? 0u : (b01 & 0xffffu)) | (use0[1] ? 0u : (b01 & 0xffff0000u));
                pwB.w = (use0[2] ? 0u : (b23 & 0xffffu)) | (use0[3] ? 0u : (b23 & 0xffff0000u));
                u32x4 pwA = (u32x4){0u, 0u, 0u, 0u};
                if (jj < 8) { const unsigned a01 = pA[jj][0], a23 = pA[jj][1];
                    pwA.x = (use0[0] ? (a01 & 0xffffu) : 0u) | (use0[1] ? (a01 & 0xffff0000u) : 0u);
                    pwA.y = (use0[2] ? (a23 & 0xffffu) : 0u) | (use0[3] ? (a23 & 0xffff0000u) : 0u);
                    pwA.z = (use0[0] ? 0u : (a01 & 0xffffu)) | (use0[1] ? 0u : (a01 & 0xffff0000u));
                    pwA.w = (use0[2] ? 0u : (a23 & 0xffffu)) | (use0[3] ? 0u : (a23 & 0xffff0000u)); }
#pragma unroll
                for (int mt = 0; mt < 4; ++mt) {
                    u32x4 vw; vw.x = vlo[mt].x; vw.y = vlo[mt].y; vw.z = vhi[mt].x; vw.w = vhi[mt].y;
                    if (jj < 8) oA[mt] = __builtin_amdgcn_mfma_f32_16x16x32_bf16(as_bf16x8(vw), as_bf16x8(pwA), oA[mt], 0, 0, 0);
                    oB[mt] = __builtin_amdgcn_mfma_f32_16x16x32_bf16(as_bf16x8(vw), as_bf16x8(pwB), oB[mt], 0, 0, 0); }
            }
        }
        const float invA = __builtin_amdgcn_rcpf(sumA), invB = __builtin_amdgcn_rcpf(sumB);
#pragma unroll
        for (int mt = 0; mt < 4; ++mt) {
            u32x2 w; w.x = cvt_pk_bf16(oA[mt][0] * invA, oA[mt][1] * invA); w.y = cvt_pk_bf16(oA[mt][2] * invA, oA[mt][3] * invA);
            *(u32x2*)(mix + (size_t)tokqA * 1024 + h * 64 + mt * 16 + 4 * g) = w;
            u32x2 w2; w2.x = cvt_pk_bf16(oB[mt][0] * invB, oB[mt][1] * invB); w2.y = cvt_pk_bf16(oB[mt][2] * invB, oB[mt][3] * invB);
            *(u32x2*)(mix + (size_t)tokqB * 1024 + h * 64 + mt * 16 + 4 * g) = w2; }
    }
}

typedef short bf16x4 __attribute__((ext_vector_type(4)));
__device__ __forceinline__ bf16x4 as_bf16x4(u32x2 v) { union { u32x2 u; bf16x4 b; } c; c.u = v; return c.b; }
__device__ __forceinline__ float sel4(float a0, float a1, float a2, float a3, int k) { return k == 0 ? a0 : (k == 1 ? a1 : (k == 2 ? a2 : a3)); }
constexpr int PL_KS = 0, PL_VS = 17408, PL_QS = 34816, PL_M1 = 52224, PL_M2 = 68864, PL_XT = 34816, PL_LB = 85504, PL_DT = 103936, PL_GC = 112128, PL_BETA = 112640, PL_EGC = 113152, PL_EGL = 113664, PL_BEG = 114176, PL_WS = 114688, PL_TB = 122880;

template <int D>
__device__ __forceinline__ void prep_attn(const int tid, unsigned char* smem, unsigned char* prep, const int bl, const int h, const int n) {
    const float* M1 = (const float*)(smem + PL_M1); const float* M2 = (const float*)(smem + PL_M2);
    bf16_t* Lb = (bf16_t*)(smem + PL_LB) + D * 64 * 72; float* DT = (float*)(smem + PL_DT) + D * 1024;
    const float* gcs = (const float*)(smem + PL_GC) + D * 64; const float* betas = (const float*)(smem + PL_BETA) + D * 64;
    const size_t pidx = ((size_t)(bl * 4 + h) * 2 + D) * 32 + (D ? 31 - n : n);
    unsigned char* pout = prep + pidx * PREP_ITEM;
    const int t = tid & 255, ip = t >> 2, jb = (t & 3) * 16;
    const float gi = gcs[ip], bi = betas[ip]; const int oi = D ? 63 - ip : ip;
    const float* m1r = M1 + oi * 65 + (D ? 63 - jb : jb); const float* m2r = M2 + oi * 65 + (D ? 63 - jb : jb);
    float av[16], lv[16];
#pragma unroll
    for (int jj = 0; jj < 16; ++jj) { const int jp = jb + jj;
        const float dec = (ip >= jp) ? __expf(gi - gcs[jp]) : 0.f;
        lv[jj] = (ip > jp) ? bi * m1r[D ? -jj : jj] * dec : 0.f;
        av[jj] = m2r[D ? -jj : jj] * dec; }
    { u32x4 w0, w1; w0.x = cvt_pk_bf16(lv[0], lv[1]); w0.y = cvt_pk_bf16(lv[2], lv[3]); w0.z = cvt_pk_bf16(lv[4], lv[5]); w0.w = cvt_pk_bf16(lv[6], lv[7]);
      w1.x = cvt_pk_bf16(lv[8], lv[9]); w1.y = cvt_pk_bf16(lv[10], lv[11]); w1.z = cvt_pk_bf16(lv[12], lv[13]); w1.w = cvt_pk_bf16(lv[14], lv[15]);
      *(u32x4*)(Lb + ip * 72 + jb) = w0; *(u32x4*)(Lb + ip * 72 + jb + 8) = w1; }
    if ((ip >> 4) == (jb >> 4)) { float* dt = DT + (ip >> 4) * 256 + (ip & 15);
#pragma unroll
        for (int jj = 0; jj < 16; ++jj) dt[jj * 16] = lv[jj]; }
    bf16_t* arow = (bf16_t*)(pout + PI_ATTN) + ip * 64 + (jb & 32) + ((jb >> 4) & 1) * 4;
#pragma unroll
    for (int gg = 0; gg < 4; ++gg) { u32x2 w; w.x = cvt_pk_bf16(av[4 * gg], av[4 * gg + 1]); w.y = cvt_pk_bf16(av[4 * gg + 2], av[4 * gg + 3]); *(u32x2*)(arow + 8 * gg) = w; }
}
template <int D>
__device__ __forceinline__ void prep_qdk(const int tid, unsigned char* smem, unsigned char* prep, float* cdarr, const int bl, const int h, const int n) {
    const bf16_t* qs = (const bf16_t*)(smem + PL_QS); const bf16_t* ks = (const bf16_t*)(smem + PL_KS);
    const float* gcs = (const float*)(smem + PL_GC) + D * 64;
    const size_t pidx = ((size_t)(bl * 4 + h) * 2 + D) * 32 + (D ? 31 - n : n);
    unsigned char* pout = prep + pidx * PREP_ITEM;
    const float* egc = (const float*)(smem + PL_EGC) + D * 64; const float* egl = (const float*)(smem + PL_EGL) + D * 64;
    const int t = tid & 255;
#pragma unroll
    for (int rep = 0; rep < 4; ++rep) { const int id = t + rep * 256, ip = id >> 4, q = id & 15, kt = q >> 2, gg = q & 3, oi = D ? 63 - ip : ip;
        const float e = egc[ip];
        const u32x2 lo = *(const u32x2*)(qs + oi * 136 + kt * 32 + 4 * gg), hi = *(const u32x2*)(qs + oi * 136 + kt * 32 + 16 + 4 * gg);
        u32x4 w; w.x = cvt_pk_bf16(bflo(lo.x) * e, bfhi(lo.x) * e); w.y = cvt_pk_bf16(bflo(lo.y) * e, bfhi(lo.y) * e);
        w.z = cvt_pk_bf16(bflo(hi.x) * e, bfhi(hi.x) * e); w.w = cvt_pk_bf16(bflo(hi.y) * e, bfhi(hi.y) * e);
        *(u32x4*)((bf16_t*)(pout + PI_QD) + ip * 128 + q * 8) = w; }
#pragma unroll
    for (int rep = 0; rep < 4; ++rep) { const int id = t + rep * 256, dk = id >> 3, q = id & 7, kt = q >> 2, gg = q & 3;
        float v[8];
#pragma unroll
        for (int sidx = 0; sidx < 8; ++sidx) { const int ip = kt * 32 + (sidx >> 2) * 16 + 4 * gg + (sidx & 3), oi = D ? 63 - ip : ip;
            v[sidx] = bf2f(ks[oi * 136 + dk]) * egl[ip]; }
        u32x4 w; w.x = cvt_pk_bf16(v[0], v[1]); w.y = cvt_pk_bf16(v[2], v[3]); w.z = cvt_pk_bf16(v[4], v[5]); w.w = cvt_pk_bf16(v[6], v[7]);
        *(u32x4*)((bf16_t*)(pout + PI_KDT) + dk * 64 + q * 8) = w; }
    if (t == 0) cdarr[pidx] = egc[63];
}
__device__ __forceinline__ void prep_inv(const int t, unsigned char* smem) {
    const int d = t >> 6, blk = (t >> 4) & 3, jj = t & 15;
    const float* DTb = (const float*)(smem + PL_DT) + d * 1024 + blk * 256;
    bf16_t* Tb = (bf16_t*)(smem + PL_TB) + (d * 4 + blk) * 256;
    float y[16];
#pragma unroll
    for (int i = 0; i < 16; ++i) y[i] = (i == jj) ? 1.f : 0.f;
#pragma unroll
    for (int k = 0; k < 15; ++k) { const float yk = y[k];
#pragma unroll
        for (int i4 = (k + 1) / 4; i4 < 4; ++i4) { const f32x4 a = *(const f32x4*)(DTb + k * 16 + i4 * 4);
#pragma unroll
            for (int q = 0; q < 4; ++q) if (i4 * 4 + q > k) y[i4 * 4 + q] -= a[q] * yk; } }
#pragma unroll
    for (int i = 0; i < 16; ++i) Tb[i * 16 + jj] = f2bf(y[i]);
}
template <int D>
__device__ __forceinline__ void prep_solve(const int tid, unsigned char* smem, unsigned char* prep, const int bl, const int h, const int n) {
    const bf16_t* ks = (const bf16_t*)(smem + PL_KS); const bf16_t* vs = (const bf16_t*)(smem + PL_VS);
    const bf16_t* Lb = (const bf16_t*)(smem + PL_LB) + D * 64 * 72; const bf16_t* Tb = (const bf16_t*)(smem + PL_TB) + D * 1024;
    bf16_t* XT = (bf16_t*)(smem + PL_XT) + D * 256 * 48;
    const size_t pidx = ((size_t)(bl * 4 + h) * 2 + D) * 32 + (D ? 31 - n : n);
    unsigned char* pout = prep + pidx * PREP_ITEM;
    const int w4 = (tid >> 6) & 3, lane = tid & 63, c = lane & 15, g = lane >> 4;
    const bool isw = w4 >= 2; const bf16_t* src = (isw ? ks : vs) + ((64 * w4 + c) & 127);
    const float* scl = (const float*)(smem + (isw ? PL_BEG : PL_BETA)) + D * 64;
    bf16_t* wst = (bf16_t*)(smem + PL_WS) + (D * 2 + (w4 & 1)) * 1024;
#pragma unroll 1
    for (int r = 0; r < 4; ++r) {
        f32x4 acc[4];
#pragma unroll
        for (int nt = 0; nt < 4; ++nt) acc[nt] = (f32x4){0.f, 0.f, 0.f, 0.f};
        for (int kk = 0; kk < r; ++kk) {
            const bf16x4 af = as_bf16x4(*(const u32x2*)(Lb + (16 * r + c) * 72 + 16 * kk + 4 * g));
#pragma unroll
            for (int nt = 0; nt < 4; ++nt) { const bf16x4 bfr = as_bf16x4(*(const u32x2*)(XT + (64 * w4 + 16 * nt + c) * 48 + 16 * kk + 4 * g));
                acc[nt] = __builtin_amdgcn_mfma_f32_16x16x16bf16_1k(af, bfr, acc[nt], 0, 0, 0); }
        }
        const f32x4 sc4 = *(const f32x4*)(scl + 16 * r + 4 * g);
        const bf16x4 tf = as_bf16x4(*(const u32x2*)(Tb + r * 256 + c * 16 + 4 * g));
        f32x4 X[4];
#pragma unroll
        for (int nt = 0; nt < 4; ++nt) { float rr[4];
#pragma unroll
            for (int i = 0; i < 4; ++i) { const int tok = 16 * r + 4 * g + i, oi = D ? 63 - tok : tok; rr[i] = bf2f(src[oi * 136 + 16 * nt]) * sc4[i] - acc[nt][i]; }
            u32x2 rb; rb.x = cvt_pk_bf16(rr[0], rr[1]); rb.y = cvt_pk_bf16(rr[2], rr[3]);
            X[nt] = __builtin_amdgcn_mfma_f32_16x16x16bf16_1k(tf, as_bf16x4(rb), (f32x4){0.f, 0.f, 0.f, 0.f}, 0, 0, 0); }
        u32x2 xb[4];
#pragma unroll
        for (int nt = 0; nt < 4; ++nt) { xb[nt].x = cvt_pk_bf16(X[nt][0], X[nt][1]); xb[nt].y = cvt_pk_bf16(X[nt][2], X[nt][3]); }
        if (r < 3) {
#pragma unroll
            for (int nt = 0; nt < 4; ++nt) *(u32x2*)(XT + (64 * w4 + 16 * nt + c) * 48 + 16 * r + 4 * g) = xb[nt]; }
        if (!isw) {
#pragma unroll
            for (int nt = 0; nt < 4; ++nt) *(u32x2*)((bf16_t*)(pout + PI_UT) + (64 * w4 + 16 * nt + c) * 64 + 16 * r + 4 * g) = xb[nt]; }
        else {
#pragma unroll
            for (int nt = 0; nt < 4; ++nt) { const int pc = perm_k(64 * (w4 & 1) + 16 * nt + c) & 63;
                wst[(4 * g + 0) * 64 + pc] = (bf16_t)(xb[nt].x & 0xffffu); wst[(4 * g + 1) * 64 + pc] = (bf16_t)(xb[nt].x >> 16);
                wst[(4 * g + 2) * 64 + pc] = (bf16_t)(xb[nt].y & 0xffffu); wst[(4 * g + 3) * 64 + pc] = (bf16_t)(xb[nt].y >> 16); }
#pragma unroll
            for (int rep = 0; rep < 2; ++rep) { const int q = lane + 64 * rep, row = q >> 3, ch = q & 7;
                const u32x4 v = *(const u32x4*)(wst + row * 64 + ch * 8);
                *(u32x4*)((bf16_t*)(pout + PI_W) + (16 * r + row) * 128 + 64 * (w4 & 1) + ch * 8) = v; }
        }
    }
}

__device__ __forceinline__ void phase_prep(const Params& p, int grp, unsigned char* smem_base) {
    const bf16_t* seg = (const bf16_t*)(p.ws + OFF_SEG);
    const float* gates = (const float*)((const unsigned char*)p.out + OOFF_GATES);
    unsigned char* prep = p.ws + OFF_PREP; float* cdarr = (float*)(p.ws + OFF_CD);
    u32x4 rows_nx[12];
    { const int tid0 = opaque_tid(), it0 = blockIdx.x;
#pragma unroll
      for (int rr = 0; rr < 12; ++rr) rows_nx[rr] = (u32x4){0u, 0u, 0u, 0u};
      if (tid0 < 384 && it0 < 3072) { const int which = tid0 >> 7, tb = (tid0 & 127) >> 4, cgp = tid0 & 15, hn = it0 & 3, nn = (it0 >> 2) & 31, bn = grp * 24 + (it0 >> 7);
#pragma unroll
        for (int rr = 0; rr < 12; ++rr) { const int pos = nn * 64 + tb * 8 - 2 + rr;
            if (pos >= 0 && pos < SEQL) rows_nx[rr] = __builtin_nontemporal_load((const u32x4*)(seg + which * 512 + ((size_t)bn * SEQL + pos) * 1536 + hn * 128 + cgp * 8)); } } }
    for (int it = blockIdx.x; it < 3072; it += gridDim.x) {
        const int h = it & 3, n = (it >> 2) & 31, bl = it >> 7, b = grp * 24 + bl;
        const int tid = opaque_tid();
        const int wid = tid >> 6, lane = tid & 63, c = lane & 15, g = lane >> 4;
        int lofs = 0; asm volatile("" : "+s"(lofs));
        unsigned char* smem = smem_base + lofs;
        bf16_t* qs = (bf16_t*)(smem + PL_QS); bf16_t* ks = (bf16_t*)(smem + PL_KS); bf16_t* vs = (bf16_t*)(smem + PL_VS);
        float* M1 = (float*)(smem + PL_M1); float* M2 = (float*)(smem + PL_M2);
        float* gcs = (float*)(smem + PL_GC); float* betas = (float*)(smem + PL_BETA);
        const size_t tok0 = (size_t)b * SEQL + n * 64;
        if (tid < 384) {
            const int which = tid >> 7, tb = (tid & 127) >> 4, cgp = tid & 15, chan = h * 128 + cgp * 8;
            const bf16_t* sg = seg + which * 512;
            float cw[5][8];
#pragma unroll
            for (int j = 0; j < 5; ++j) { const f32x4 w0 = *(const f32x4*)(p.gconv + j * 1536 + which * 512 + chan), w1 = *(const f32x4*)(p.gconv + j * 1536 + which * 512 + chan + 4);
                cw[j][0] = w0[0]; cw[j][1] = w0[1]; cw[j][2] = w0[2]; cw[j][3] = w0[3]; cw[j][4] = w1[0]; cw[j][5] = w1[1]; cw[j][6] = w1[2]; cw[j][7] = w1[3]; }
            u32x4 rows[12];
#pragma unroll
            for (int rr = 0; rr < 12; ++rr) rows[rr] = rows_nx[rr];
            bf16_t* dst = (which == 0 ? qs : (which == 1 ? ks : vs)) + cgp * 8;
#pragma unroll
            for (int tt = 0; tt < 8; ++tt) {
                float y[8];
#pragma unroll
                for (int e = 0; e < 8; ++e) y[e] = 0.f;
#pragma unroll
                for (int j = 0; j < 5; ++j) { const u32x4 rv = rows[tt + j];
                    y[0] += cw[j][0] * bflo(rv.x); y[1] += cw[j][1] * bfhi(rv.x); y[2] += cw[j][2] * bflo(rv.y); y[3] += cw[j][3] * bfhi(rv.y);
                    y[4] += cw[j][4] * bflo(rv.z); y[5] += cw[j][5] * bfhi(rv.z); y[6] += cw[j][6] * bflo(rv.w); y[7] += cw[j][7] * bfhi(rv.w); }
                float ss = 0.f;
#pragma unroll
                for (int e = 0; e < 8; ++e) { y[e] = silu_f(y[e]); ss += y[e] * y[e]; }
                ss += __shfl_xor(ss, 1); ss += __shfl_xor(ss, 2); ss += __shfl_xor(ss, 4); ss += __shfl_xor(ss, 8);
                const float sc = (which == 0) ? rsqrtf(ss + 1e-6f) * 0.08838834764831845f : ((which == 1) ? rsqrtf(ss + 1e-6f) : 1.f);
                u32x4 w; w.x = cvt_pk_bf16(y[0] * sc, y[1] * sc); w.y = cvt_pk_bf16(y[2] * sc, y[3] * sc); w.z = cvt_pk_bf16(y[4] * sc, y[5] * sc); w.w = cvt_pk_bf16(y[6] * sc, y[7] * sc);
                *(u32x4*)(dst + (tb * 8 + tt) * 136) = w;
            }
            { const int itn = it + gridDim.x;
              if (itn < 3072) { const int hn = itn & 3, nn = (itn >> 2) & 31, bn = grp * 24 + (itn >> 7);
#pragma unroll
                for (int rr = 0; rr < 12; ++rr) { const int pos = nn * 64 + tb * 8 - 2 + rr; rows_nx[rr] = (u32x4){0u, 0u, 0u, 0u};
                    if (pos >= 0 && pos < SEQL) rows_nx[rr] = __builtin_nontemporal_load((const u32x4*)(seg + which * 512 + ((size_t)bn * SEQL + pos) * 1536 + hn * 128 + cgp * 8)); } } }
        } else if (wid >= 6) {
            const int d = wid - 6, li = d ? 63 - lane : lane;
            const float* gr = gates + (tok0 + li) * 16;
            const float bet = sigmoid_f(gr[d * 4 + h]);
            const float a = gr[8 + d * 4 + h] + p.dt_bias[d * 4 + h];
            const float sp = fmaxf(a, 0.f) + log1pf(__expf(-fabsf(a)));
            float gv = -__expf(p.a_log[d * 4 + h]) * sp;
#pragma unroll
            for (int off = 1; off < 64; off <<= 1) { const float t = __shfl_up(gv, off); if (lane >= off) gv += t; }
            gcs[d * 64 + lane] = gv; betas[d * 64 + lane] = bet;
            { const float eg = __expf(gv), gl = __shfl(gv, 63);
              ((float*)(smem + PL_EGC))[d * 64 + lane] = eg; ((float*)(smem + PL_EGL))[d * 64 + lane] = __expf(gl - gv); ((float*)(smem + PL_BEG))[d * 64 + lane] = bet * eg; }
        }
        __syncthreads();
        {
            const int which = wid >> 2, mt = wid & 3; const bf16_t* X = which ? qs : ks; float* M = which ? M2 : M1;
            bf16x8 af[4];
#pragma unroll
            for (int kk = 0; kk < 4; ++kk) af[kk] = *(const bf16x8*)(X + (mt * 16 + c) * 136 + kk * 32 + 8 * g);
#pragma unroll
            for (int nt = 0; nt < 4; ++nt) { f32x4 a = (f32x4){0.f, 0.f, 0.f, 0.f};
#pragma unroll
                for (int kk = 0; kk < 4; ++kk) { const bf16x8 bfr = *(const bf16x8*)(ks + (nt * 16 + c) * 136 + kk * 32 + 8 * g);
                    a = __builtin_amdgcn_mfma_f32_16x16x32_bf16(af[kk], bfr, a, 0, 0, 0); }
#pragma unroll
                for (int i = 0; i < 4; ++i) M[(mt * 16 + 4 * g + i) * 65 + nt * 16 + c] = a[i]; }
        }
        __syncthreads();
        if (tid < 256) prep_attn<0>(tid, smem, prep, bl, h, n); else prep_attn<1>(tid, smem, prep, bl, h, n);
        __syncthreads();
        if (tid < 128) prep_inv(tid, smem);
        if (tid < 256) prep_qdk<0>(tid, smem, prep, cdarr, bl, h, n); else prep_qdk<1>(tid, smem, prep, cdarr, bl, h, n);
        __syncthreads();
        if (tid < 256) prep_solve<0>(tid, smem, prep, bl, h, n); else prep_solve<1>(tid, smem, prep, bl, h, n);
        __syncthreads();
    }
}

constexpr int SL_W = 0, SL_QD = 17408, SL_ATTN = 34816, SL_KDT = 44032;
__device__ __forceinline__ void phase_scan(const Params& p, int grp, unsigned char* smem) {
    const int tid = opaque_tid(), wv = tid >> 6, lane = tid & 63, c = lane & 15, g = lane >> 4;
    const unsigned char* prep = p.ws + OFF_PREP; const float* cdarr = (const float*)(p.ws + OFF_CD);
    bf16_t* O4 = (bf16_t*)((unsigned char*)p.out + OOFF_O);
    (void)grp;
    constexpr int SBUF = 62464;
    for (int it = blockIdx.x; it < 192; it += gridDim.x) {
        const int d = it & 1, h = (it >> 1) & 3, bl = it >> 3;
        const unsigned char* pbase = prep + (size_t)it * 32 * PREP_ITEM; const float* cdp = cdarr + (size_t)it * 32;
        f32x4 S[8];
#pragma unroll
        for (int m = 0; m < 8; ++m) S[m] = (f32x4){0.f, 0.f, 0.f, 0.f};
        u32x4 st[7];
#define SCAN_LOAD(src) do { _Pragma("unroll") for (int k = 0; k < 7; ++k) st[k] = __builtin_nontemporal_load((const u32x4*)((src) + (size_t)(tid + 512 * k) * 16)); } while (0)
#define SCAN_STORE(sb) do { \
        _Pragma("unroll") for (int k = 0; k < 2; ++k) { const int id = tid + 512 * k; *(u32x4*)((sb) + SL_W + (id >> 4) * 272 + (id & 15) * 16) = st[k]; } \
        _Pragma("unroll") for (int k = 2; k < 4; ++k) { const int id = tid + 512 * (k - 2); *(u32x4*)((sb) + SL_QD + (id >> 4) * 272 + (id & 15) * 16) = st[k]; } \
        { const int id = tid; *(u32x4*)((sb) + SL_ATTN + (id >> 3) * 144 + (id & 7) * 16) = st[4]; } \
        _Pragma("unroll") for (int k = 5; k < 7; ++k) { const int id = tid + 512 * (k - 5); *(u32x4*)((sb) + SL_KDT + (id >> 3) * 144 + (id & 7) * 16) = st[k]; } } while (0)
        SCAN_LOAD(pbase); SCAN_STORE(smem);
        SCAN_LOAD(pbase + PREP_ITEM);
        u32x2 uun[4]; float cdn = cdp[0];
#pragma unroll
        for (int mt = 0; mt < 4; ++mt) uun[mt] = *(const u32x2*)(pbase + PI_UT + ((16 * wv + c) * 64 + 16 * mt + 4 * g) * 2);
        __syncthreads();
        for (int n = 0; n < 32; ++n) {
            const unsigned char* cur = pbase + (size_t)n * PREP_ITEM;
            unsigned char* sb = smem + (n & 1) * SBUF;
            if (n < 31) SCAN_STORE(smem + ((n + 1) & 1) * SBUF);
            if (n < 30) SCAN_LOAD(cur + 2 * PREP_ITEM);
            u32x2 uu[4]; const float cdv = cdn;
#pragma unroll
            for (int mt = 0; mt < 4; ++mt) uu[mt] = uun[mt];
            if (n < 31) { cdn = cdp[n + 1];
#pragma unroll
                for (int mt = 0; mt < 4; ++mt) uun[mt] = *(const u32x2*)(cur + PREP_ITEM + PI_UT + ((16 * wv + c) * 64 + 16 * mt + 4 * g) * 2); }
            bf16x8 Sb[4];
#pragma unroll
            for (int kt = 0; kt < 4; ++kt) { u32x4 w; w.x = cvt_pk_bf16(S[2 * kt][0], S[2 * kt][1]); w.y = cvt_pk_bf16(S[2 * kt][2], S[2 * kt][3]);
                w.z = cvt_pk_bf16(S[2 * kt + 1][0], S[2 * kt + 1][1]); w.w = cvt_pk_bf16(S[2 * kt + 1][2], S[2 * kt + 1][3]); Sb[kt] = as_bf16x8(w); }
            f32x4 av[4], ao[4];
#pragma unroll
            for (int mt = 0; mt < 4; ++mt) { f32x4 a = (f32x4){0.f, 0.f, 0.f, 0.f};
#pragma unroll
                for (int kt = 0; kt < 4; ++kt) { const bf16x8 af = *(const bf16x8*)(sb + SL_W + (16 * mt + c) * 272 + (32 * kt + 8 * g) * 2);
                    a = __builtin_amdgcn_mfma_f32_16x16x32_bf16(af, Sb[kt], a, 0, 0, 0); }
                av[mt] = a; }
#pragma unroll
            for (int mt = 0; mt < 4; ++mt) { f32x4 a = (f32x4){0.f, 0.f, 0.f, 0.f};
#pragma unroll
                for (int kt = 0; kt < 4; ++kt) { const bf16x8 af = *(const bf16x8*)(sb + SL_QD + (16 * mt + c) * 272 + (32 * kt + 8 * g) * 2);
                    a = __builtin_amdgcn_mfma_f32_16x16x32_bf16(af, Sb[kt], a, 0, 0, 0); }
                ao[mt] = a; }
            f32x4 v[4];
#pragma unroll
            for (int mt = 0; mt < 4; ++mt) v[mt] = (f32x4){bflo(uu[mt].x) - av[mt][0], bfhi(uu[mt].x) - av[mt][1], bflo(uu[mt].y) - av[mt][2], bfhi(uu[mt].y) - av[mt][3]};
            bf16x8 Vb[2];
#pragma unroll
            for (int kt = 0; kt < 2; ++kt) { u32x4 w; w.x = cvt_pk_bf16(v[2 * kt][0], v[2 * kt][1]); w.y = cvt_pk_bf16(v[2 * kt][2], v[2 * kt][3]);
                w.z = cvt_pk_bf16(v[2 * kt + 1][0], v[2 * kt + 1][1]); w.w = cvt_pk_bf16(v[2 * kt + 1][2], v[2 * kt + 1][3]); Vb[kt] = as_bf16x8(w); }
            const int no = d ? 31 - n : n;
#pragma unroll
            for (int mt = 0; mt < 4; ++mt) { f32x4 a = ao[mt];
#pragma unroll
                for (int kt = 0; kt < 2; ++kt) { const bf16x8 af = *(const bf16x8*)(sb + SL_ATTN + (16 * mt + c) * 144 + (32 * kt + 8 * g) * 2);
                    a = __builtin_amdgcn_mfma_f32_16x16x32_bf16(af, Vb[kt], a, 0, 0, 0); }
                ao[mt] = a; }
#pragma unroll
            for (int m8 = 0; m8 < 8; ++m8) { f32x4 a = S[m8] * cdv;
#pragma unroll
                for (int kt = 0; kt < 2; ++kt) { const bf16x8 af = *(const bf16x8*)(sb + SL_KDT + (16 * m8 + c) * 144 + (32 * kt + 8 * g) * 2);
                    a = __builtin_amdgcn_mfma_f32_16x16x32_bf16(af, Vb[kt], a, 0, 0, 0); }
                S[m8] = a; }
#pragma unroll
            for (int mt = 0; mt < 4; ++mt) {
                const int l0 = d ? 60 - 16 * mt - 4 * g : 16 * mt + 4 * g;
                u32x2 w; if (d) { w.x = cvt_pk_bf16(ao[mt][3], ao[mt][2]); w.y = cvt_pk_bf16(ao[mt][1], ao[mt][0]); }
                else { w.x = cvt_pk_bf16(ao[mt][0], ao[mt][1]); w.y = cvt_pk_bf16(ao[mt][2], ao[mt][3]); }
                *(u32x2*)(O4 + (((size_t)d * 12288 + (((size_t)bl * SEQL + no * 64 + l0) >> 2)) * 512 + h * 128 + 16 * wv + c) * 4) = w; }
            __syncthreads();
        }
#undef SCAN_LOAD
#undef SCAN_STORE
    }
}

__device__ __forceinline__ void phase_combine(const Params& p, int grp) {
    const bf16_t* O4 = (const bf16_t*)((const unsigned char*)p.out + OOFF_O);
    const bf16_t* Z = (const bf16_t*)((const unsigned char*)p.out + OOFF_Z);
    bf16_t* mix = (bf16_t*)(p.ws + OFF_MIX);
    const int total = 12288 * 4 * 32, nthr = gridDim.x * 512;
    const int q = opaque_tid() & 31;
    const f32x4 nwv = *(const f32x4*)(p.gnorm + 4 * q);
    for (int gt = blockIdx.x * 512 + opaque_tid(); gt < total; gt += nthr) {
        const int h = (gt >> 5) & 3, tg4 = gt >> 7;
        const bf16_t* of = O4 + ((size_t)tg4 * 512 + h * 128 + 4 * q) * 4; const bf16_t* ob = of + (size_t)12288 * 512 * 4;
        const u32x4 f0 = __builtin_nontemporal_load((const u32x4*)of), f1 = __builtin_nontemporal_load((const u32x4*)(of + 8)), b0 = __builtin_nontemporal_load((const u32x4*)ob), b1 = __builtin_nontemporal_load((const u32x4*)(ob + 8));
        const size_t tokg = (size_t)grp * 49152 + (size_t)tg4 * 4;
        u32x2 zv[4];
#pragma unroll
        for (int t = 0; t < 4; ++t) zv[t] = *(const u32x2*)(Z + (tokg + t) * 512 + h * 128 + 4 * q);
        const unsigned fw[8] = {f0.x, f0.y, f0.z, f0.w, f1.x, f1.y, f1.z, f1.w}, bw[8] = {b0.x, b0.y, b0.z, b0.w, b1.x, b1.y, b1.z, b1.w};
        float o[4][4];
#pragma unroll
        for (int j = 0; j < 4; ++j) { o[j][0] = bflo(fw[2 * j]) + bflo(bw[2 * j]); o[j][1] = bfhi(fw[2 * j]) + bfhi(bw[2 * j]);
            o[j][2] = bflo(fw[2 * j + 1]) + bflo(bw[2 * j + 1]); o[j][3] = bfhi(fw[2 * j + 1]) + bfhi(bw[2 * j + 1]); }
#pragma unroll
        for (int t = 0; t < 4; ++t) {
            float ss = (o[0][t] * o[0][t] + o[1][t] * o[1][t]) + (o[2][t] * o[2][t] + o[3][t] * o[3][t]);
            ss += __shfl_xor(ss, 1); ss += __shfl_xor(ss, 2); ss += __shfl_xor(ss, 4); ss += __shfl_xor(ss, 8); ss += __shfl_xor(ss, 16);
            const float r = rsqrtf(ss * (1.f / 128.f) + 1e-6f);
            const float z0 = bflo(zv[t].x), z1 = bfhi(zv[t].x), z2 = bflo(zv[t].y), z3 = bfhi(zv[t].y);
            u32x2 w; w.x = cvt_pk_bf16(o[0][t] * r * nwv[0] * silu_f(z0), o[1][t] * r * nwv[1] * silu_f(z1)); w.y = cvt_pk_bf16(o[2][t] * r * nwv[2] * silu_f(z2), o[3][t] * r * nwv[3] * silu_f(z3));
            *(u32x2*)(mix + (tokg + t) * 1024 + 512 + h * 128 + 4 * q) = w; }
    }
}

template <bool OUT_BF16, int IN_BF16>
__device__ __forceinline__ void phase_ln(const void* inp, const void* inp2, const void* inp3, void* outp, const float* gam, const float* bet, const int row_lo, const int row_hi) {
    const int tid = opaque_tid(), wid = tid >> 6, lane = tid & 63;
    f32x4 gv[4], bv[4];
#pragma unroll
    for (int j = 0; j < 4; ++j) { gv[j] = *(const f32x4*)(gam + j * 256 + lane * 4); bv[j] = *(const f32x4*)(bet + j * 256 + lane * 4); }
    for (int row0 = row_lo + (blockIdx.x * 8 + wid) * 4; row0 < row_hi; row0 += gridDim.x * 32) {
        f32x4 v[4][4]; float s[4] = {0.f, 0.f, 0.f, 0.f}, s2[4] = {0.f, 0.f, 0.f, 0.f};
#pragma unroll
        for (int rr = 0; rr < 4; ++rr)
#pragma unroll
            for (int j = 0; j < 4; ++j) {
                if (IN_BF16 == 3) { const int row = row0 + rr; const float* xr = (row < T_PROMPT) ? (const float*)inp + (size_t)row * 1024 : (const float*)inp3 + (size_t)(row - T_PROMPT) * 1024;
                    const f32x4 xv = __builtin_nontemporal_load((const f32x4*)(xr + lane * 4 + j * 256)); const u32x2 fv = __builtin_nontemporal_load((const u32x2*)((const bf16_t*)inp2 + (size_t)row * 1024 + lane * 4 + j * 256));
                    v[rr][j] = (f32x4){DN_ALPHA * xv[0] + bflo(fv.x), DN_ALPHA * xv[1] + bfhi(fv.x), DN_ALPHA * xv[2] + bflo(fv.y), DN_ALPHA * xv[3] + bfhi(fv.y)}; }
                else if (IN_BF16 == 2) { const u32x2 hv = __builtin_nontemporal_load((const u32x2*)((const bf16_t*)inp + (size_t)(row0 + rr) * 1024 + lane * 4 + j * 256)), fv = __builtin_nontemporal_load((const u32x2*)((const bf16_t*)inp2 + (size_t)(row0 + rr) * 1024 + lane * 4 + j * 256));
                    v[rr][j] = (f32x4){DN_ALPHA * bflo(hv.x) + bflo(fv.x), DN_ALPHA * bfhi(hv.x) + bfhi(fv.x), DN_ALPHA * bflo(hv.y) + bflo(fv.y), DN_ALPHA * bfhi(hv.y) + bfhi(fv.y)}; }
                else if (IN_BF16 == 1) { const u32x2 hv = *(const u32x2*)((const bf16_t*)inp + (size_t)(row0 + rr) * 1024 + lane * 4 + j * 256); v[rr][j] = (f32x4){bflo(hv.x), bfhi(hv.x), bflo(hv.y), bfhi(hv.y)}; }
                else v[rr][j] = *(const f32x4*)((const float*)inp + (size_t)(row0 + rr) * 1024 + lane * 4 + j * 256); }
#pragma unroll
        for (int rr = 0; rr < 4; ++rr) {
#pragma unroll
            for (int j = 0; j < 4; ++j) s[rr] += (v[rr][j][0] + v[rr][j][1]) + (v[rr][j][2] + v[rr][j][3]);
#pragma unroll
            for (int o = 1; o < 64; o <<= 1) s[rr] += __shfl_xor(s[rr], o);
            const float mean = s[rr] * (1.f / 1024.f);
#pragma unroll
            for (int j = 0; j < 4; ++j) { v[rr][j] = v[rr][j] - mean; s2[rr] += (v[rr][j][0] * v[rr][j][0] + v[rr][j][1] * v[rr][j][1]) + (v[rr][j][2] * v[rr][j][2] + v[rr][j][3] * v[rr][j][3]); }
#pragma unroll
            for (int o = 1; o < 64; o <<= 1) s2[rr] += __shfl_xor(s2[rr], o);
            const float rstd = rsqrtf(s2[rr] * (1.f / 1024.f) + 1e-5f);
#pragma unroll
            for (int j = 0; j < 4; ++j) { const f32x4 y = v[rr][j] * rstd * gv[j] + bv[j];
                if (OUT_BF16) { u32x2 w; w.x = cvt_pk_bf16(y[0], y[1]); w.y = cvt_pk_bf16(y[2], y[3]); *(u32x2*)((bf16_t*)outp + (size_t)(row0 + rr) * 1024 + j * 256 + lane * 4) = w; }
                else __builtin_nontemporal_store(y, (f32x4*)((float*)outp + (size_t)(row0 + rr) * 1024 + j * 256 + lane * 4)); }
        }
    }
}

__device__ __forceinline__ void phase_ffnact(const Params& p) {
    const bf16_t* hdn = (const bf16_t*)(p.ws + OFF_HDN); bf16_t* act = (bf16_t*)(p.ws + OFF_ACT);
    const int total = 4096 * 352, nthr = gridDim.x * 512;
    for (int idx = blockIdx.x * 512 + opaque_tid(); idx < total; idx += nthr) {
        const int cgp = idx % 352, tblk = idx / 352, c0 = cgp * 8, t0 = tblk * 8, pos0 = t0 & (SEQL - 1);
        const bf16_t* hp = hdn + (size_t)t0 * 5632 + c0;
        const u32x4 zero4 = (u32x4){0u, 0u, 0u, 0u};
        u32x4 gr[10], vr[10];
#pragma unroll
        for (int rr = 0; rr < 10; ++rr) { const int pos = pos0 - 1 + rr; gr[rr] = zero4; vr[rr] = zero4;
            if (pos >= 0 && pos < SEQL) { gr[rr] = __builtin_nontemporal_load((const u32x4*)(hp + (ptrdiff_t)(rr - 1) * 5632)); vr[rr] = __builtin_nontemporal_load((const u32x4*)(hp + (ptrdiff_t)(rr - 1) * 5632 + 2816)); } }
        float wg_[3][8], wv_[3][8], bg[8], bv[8];
#pragma unroll
        for (int j = 0; j < 3; ++j) { const f32x4 a0 = *(const f32x4*)(p.fconvw + j * 5632 + c0), a1 = *(const f32x4*)(p.fconvw + j * 5632 + c0 + 4);
            const f32x4 b0 = *(const f32x4*)(p.fconvw + j * 5632 + 2816 + c0), b1 = *(const f32x4*)(p.fconvw + j * 5632 + 2816 + c0 + 4);
#pragma unroll
            for (int e = 0; e < 4; ++e) { wg_[j][e] = a0[e]; wg_[j][4 + e] = a1[e]; wv_[j][e] = b0[e]; wv_[j][4 + e] = b1[e]; } }
        { const f32x4 a0 = *(const f32x4*)(p.fconvb + c0), a1 = *(const f32x4*)(p.fconvb + c0 + 4), b0 = *(const f32x4*)(p.fconvb + 2816 + c0), b1 = *(const f32x4*)(p.fconvb + 2816 + c0 + 4);
#pragma unroll
          for (int e = 0; e < 4; ++e) { bg[e] = a0[e]; bg[4 + e] = a1[e]; bv[e] = b0[e]; bv[4 + e] = b1[e]; } }
#pragma unroll
        for (int tt = 0; tt < 8; ++tt) {
            const unsigned gpa[4] = {gr[tt].x, gr[tt].y, gr[tt].z, gr[tt].w}, gca[4] = {gr[tt + 1].x, gr[tt + 1].y, gr[tt + 1].z, gr[tt + 1].w}, gna[4] = {gr[tt + 2].x, gr[tt + 2].y, gr[tt + 2].z, gr[tt + 2].w};
            const unsigned vpa[4] = {vr[tt].x, vr[tt].y, vr[tt].z, vr[tt].w}, vca[4] = {vr[tt + 1].x, vr[tt + 1].y, vr[tt + 1].z, vr[tt + 1].w}, vna[4] = {vr[tt + 2].x, vr[tt + 2].y, vr[tt + 2].z, vr[tt + 2].w};
            float y[8];
#pragma unroll
            for (int q = 0; q < 4; ++q) {
                const float G0 = wg_[0][2 * q] * bflo(gpa[q]) + wg_[1][2 * q] * bflo(gca[q]) + wg_[2][2 * q] * bflo(gna[q]) + bg[2 * q];
                const float G1 = wg_[0][2 * q + 1] * bfhi(gpa[q]) + wg_[1][2 * q + 1] * bfhi(gca[q]) + wg_[2][2 * q + 1] * bfhi(gna[q]) + bg[2 * q + 1];
                const float V0 = wv_[0][2 * q] * bflo(vpa[q]) + wv_[1][2 * q] * bflo(vca[q]) + wv_[2][2 * q] * bflo(vna[q]) + bv[2 * q];
                const float V1 = wv_[0][2 * q + 1] * bfhi(vpa[q]) + wv_[1][2 * q + 1] * bfhi(vca[q]) + wv_[2][2 * q + 1] * bfhi(vna[q]) + bv[2 * q + 1];
                y[2 * q] = silu_f(G0) * V0; y[2 * q + 1] = silu_f(G1) * V1; }
            u32x4 w; w.x = cvt_pk_bf16(y[0], y[1]); w.y = cvt_pk_bf16(y[2], y[3]); w.z = cvt_pk_bf16(y[4], y[5]); w.w = cvt_pk_bf16(y[6], y[7]);
            *(u32x4*)(act + (size_t)(t0 + tt) * 2816 + c0) = w;
        }
    }
}

#define XB_TMO      128
#define XB_XCNT(j)  (256  + 64 * (j))
#define XB_XSUB(j)  (1280 + 64 * (j))
#define XB_XGEN(j)  (2304 + 64 * (j))
#define XB_TOP      3328
#define XB_TOPGEN   3392
#define XCD_BAR_WORDS 3456
#define XB_SPIN_CAP (1u << 20)
__device__ __forceinline__ unsigned xb_ld(unsigned* p)              { return __hip_atomic_load(p, __ATOMIC_RELAXED, __HIP_MEMORY_SCOPE_AGENT); }
__device__ __forceinline__ unsigned xb_add(unsigned* p, unsigned v) { return __hip_atomic_fetch_add(p, v, __ATOMIC_RELAXED, __HIP_MEMORY_SCOPE_AGENT); }
__device__ __forceinline__ unsigned xb_xcc_id() { return (unsigned)__builtin_amdgcn_s_getreg((3 << 11) | 20) & 0xFu; }
#define XB_SPIN(cond, bar) do { unsigned _sp = 0; while (cond) { __builtin_amdgcn_s_sleep(1); \
    if ((++_sp & 255u) == 0u) { if (xb_ld(&(bar)[XB_TMO])) break; if (_sp > XB_SPIN_CAP) { atomicAdd(&(bar)[XB_TMO], 1u); break; } } } } while (0)
struct XcdBarrier { unsigned* bar; unsigned x; volatile LAS unsigned* st; };
__device__ __forceinline__ XcdBarrier xcd_barrier_post(unsigned* bar, volatile LAS unsigned* st) {
    XcdBarrier b; b.bar = bar; b.x = xb_xcc_id(); b.st = st;
    if (threadIdx.x == 0) (void)xb_add(&bar[XB_XCNT(b.x)], 1u);
    return b;
}
__device__ __forceinline__ void xcd_barrier_complete(unsigned* bar, unsigned x, unsigned& nloc, unsigned& nx) {
    const unsigned G = gridDim.x * gridDim.y * gridDim.z;
    unsigned sum, cnt, mine, sp = 0u;
    for (;;) {
        sum = 0u; cnt = 0u; mine = 0u;
#pragma unroll
        for (unsigned j = 0; j < 16; ++j) { const unsigned c = xb_ld(&bar[XB_XCNT(j)]); sum += c; cnt += (c > 0u) ? 1u : 0u; mine = (j == x) ? c : mine; }
        if (sum == G) break;
        __builtin_amdgcn_s_sleep(1);
        if ((++sp & 255u) == 0u) { if (xb_ld(&bar[XB_TMO])) break; if (sp > XB_SPIN_CAP) { atomicAdd(&bar[XB_TMO], 1u); break; } }
    }
    nloc = mine > 0u ? mine : 1u; nx = cnt > 0u ? cnt : 1u;
}
__device__ __forceinline__ void xcd_barrier(const XcdBarrier& b) {
    asm volatile("s_waitcnt vmcnt(0)" ::: "memory");
    __syncthreads();
    if (threadIdx.x == 0) {
        unsigned* bar = b.bar;
        __builtin_amdgcn_s_waitcnt(0);
        unsigned nloc = b.st[0], nx = b.st[1];
        if (nloc == 0u) { xcd_barrier_complete(bar, b.x, nloc, nx); b.st[0] = nloc; b.st[1] = nx; }
        const unsigned old = xb_add(&bar[XB_XSUB(b.x)], 1u);
        const unsigned gen = old / nloc;
        if (old + 1u == (gen + 1u) * nloc) {
            __builtin_amdgcn_fence(__ATOMIC_RELEASE, "agent");
            asm volatile("s_waitcnt vmcnt(0)" ::: "memory");
            const unsigned og = xb_add(&bar[XB_TOP], 1u);
            const unsigned tg = og / nx;
            if (og + 1u == (tg + 1u) * nx) xb_add(&bar[XB_TOPGEN], 1u);
            else XB_SPIN(xb_ld(&bar[XB_TOPGEN]) == tg, bar);
            __builtin_amdgcn_fence(__ATOMIC_ACQUIRE, "agent");
            xb_add(&bar[XB_XGEN(b.x)], 1u);
            asm volatile("s_waitcnt vmcnt(0)" ::: "memory");
        } else {
            XB_SPIN(xb_ld(&bar[XB_XGEN(b.x)]) == gen, bar);
            __builtin_amdgcn_fence(__ATOMIC_ACQUIRE, "agent");
            asm volatile("s_waitcnt vmcnt(0)" ::: "memory");
        }
    }
    __syncthreads();
}


__device__ __forceinline__ void ffn_up(const Params& p, const int fg, LAS unsigned char* lds, pg8::StaticOrder& S) {
    pg8::Gemm g{(const bf16_t*)(p.ws + OFF_X1) + (size_t)fg * 32768 * 1024, (const bf16_t*)(p.ws + OFF_WUP), 32768, 5632, 1024};
    pg8::EpiBf16 E{(bf16_t*)(p.ws + OFF_HDN), 5632};
    S.init(g.M, g.N, gridDim.x, blockIdx.x); pg8::gemm_phase(lds, g, S, E);
}
__device__ __forceinline__ void ffn_down(const Params& p, const int fg, LAS unsigned char* lds, pg8::StaticOrder& S) {
    pg8::Gemm g{(const bf16_t*)(p.ws + OFF_ACT), (const bf16_t*)(p.ws + OFF_WDOWN), 32768, 1024, 2816};
    pg8::EpiBf16 E{(bf16_t*)(p.ws + OFF_FFNB) + (size_t)fg * 32768 * 1024, 1024};
    S.init(g.M, g.N, gridDim.x, blockIdx.x); pg8::gemm_phase(lds, g, S, E);
}
#ifndef ONLY
#define ONLY -1
#endif
#define EN(k) (ONLY < 0 || ONLY == (k))
constexpr int N_STEPS = 18;
#ifndef DUP_MASK
#define DUP_MASK 0
#endif
__device__ __forceinline__ void run_step(const Params& p, int step, unsigned char* smem) {
    LAS unsigned char* lds = (LAS unsigned char*)smem;
    pg8::StaticOrder S;
    switch (step) {
    case 0: if (EN(0)) { phase_wprep(p, smem, 0, blockIdx.x, gridDim.x); phase_xconv(p, smem); } break;
    case 1: if (EN(1)) {
        const bf16_t* xb = (const bf16_t*)(p.ws + OFF_XB); const bf16_t* wm = (const bf16_t*)(p.ws + OFF_WMAIN);
        { pg8::Gemm g{xb, wm, T_TOK, 1536, 1024}; pg8::EpiBf16 E{(bf16_t*)(p.ws + OFF_SEG), 1536};
          S.init(g.M, g.N, gridDim.x, blockIdx.x); pg8::gemm_phase(lds, g, S, E); }
        { pg8::Gemm g{xb, wm + (size_t)1536 * 1024, T_TOK, 1024, 1024}; pg8::EpiNAqk E{(bf16_t*)(p.ws + OFF_NA2)};
          S.init(g.M, g.N, gridDim.x, blockIdx.x); pg8::gemm_phase(lds, g, S, E); }
        { pg8::Gemm g{xb, wm + (size_t)2560 * 1024, T_TOK, 512, 1024}; pg8::EpiBf16 E{(bf16_t*)((unsigned char*)p.out + OOFF_Z), 512};
          S.init(g.M, g.N, gridDim.x, blockIdx.x); pg8::gemm_phase(lds, g, S, E); }
        { pg8::Gemm g{(const bf16_t*)(p.ws + OFF_WV), xb, 512, T_TOK, 1024}; pg8::EpiVT E{(bf16_t*)(p.ws + OFF_VT)};
          S.init(g.M, g.N, gridDim.x, blockIdx.x); pg8::gemm_phase(lds, g, S, E); }
    } break;
    case 2: if (EN(2)) phase_na(p, smem); break;
    case 3: if (EN(3)) phase_prep(p, 0, smem); break;
    case 4: if (EN(4)) { phase_scan(p, 0, smem);
              if (gridDim.x > 192) { if (blockIdx.x >= 192) phase_wprep(p, smem, 1, blockIdx.x - 192, gridDim.x - 192); }
              else phase_wprep(p, smem, 1, blockIdx.x, gridDim.x); } break;
    case 5: if (EN(5)) { for (int k = 0; k < 2; ++k) { if ((k == 0) != ((blockIdx.x & 1) != 0)) phase_combine(p, 0); else phase_prep(p, 1, smem); __syncthreads(); } } break;
    case 6: if (EN(4)) { phase_scan(p, 1, smem);
              if (gridDim.x > 192) { if (blockIdx.x >= 192) phase_wprep(p, smem, 2, blockIdx.x - 192, gridDim.x - 192); }
              else phase_wprep(p, smem, 2, blockIdx.x, gridDim.x); } break;
    case 7: if (EN(5)) phase_combine(p, 1); break;
    case 8: if (EN(8)) { pg8::Gemm g{(const bf16_t*)(p.ws + OFF_MIX), (const bf16_t*)(p.ws + OFF_WOUT), T_TOK, 1024, 1024};
              pg8::EpiBf16 E{(bf16_t*)(p.ws + OFF_H1), 1024};
              S.init(g.M, g.N, gridDim.x, blockIdx.x); pg8::gemm_phase(lds, g, S, E); } break;
    case 9: if (EN(9)) phase_ln<true, 3>(p.xp, p.ws + OFF_H1, p.xs, p.ws + OFF_X1, p.ln1g, p.ln1b, 0, T_TOK); break;
    case 10: if (EN(10)) ffn_up(p, 0, lds, S); break;
    case 11: case 13: case 15: if (EN(11)) phase_ffnact(p); break;
    case 12: if (EN(12)) { ffn_down(p, 0, lds, S); ffn_up(p, 1, lds, S); } break;
    case 14: case 16: if (EN(12)) {
              const int fg = (step - 12) / 2;
              for (int k = 0; k < 2; ++k) {
                  if ((k == 0) != ((blockIdx.x & 1) != 0)) phase_ln<false, 2>(p.ws + OFF_X1, p.ws + OFF_FFNB, nullptr, p.out, p.ln2g, p.ln2b, (fg - 1) * 32768, fg * 32768);
                  else { ffn_down(p, fg, lds, S); if (fg < 2) ffn_up(p, fg + 1, lds, S); }
                  __syncthreads(); } } break;
    case 17: if (EN(9)) phase_ln<false, 2>(p.ws + OFF_X1, p.ws + OFF_FFNB, nullptr, p.out, p.ln2g, p.ln2b, 65536, T_TOK); break;
    default: break;
    }
}

template <bool COOP>
__global__ void __launch_bounds__(512, 2) mega(Params p, int s0, int s1) {
    extern __shared__ __attribute__((aligned(16))) unsigned char smem[];
    XcdBarrier xb;
    if (COOP) {
        volatile LAS unsigned* st = (volatile LAS unsigned*)((LAS unsigned char*)smem + LDS_BAR_OFF);
        if (threadIdx.x == 0) { st[0] = 0u; st[1] = 0u; }
        __syncthreads();
        xb = xcd_barrier_post((unsigned*)(p.ws + OFF_BAR), st);
    }
    for (int s = s0; s < s1; ++s) {
        const int nrep = 1 + ((DUP_MASK >> s) & 1);
        for (int rep = 0; rep < nrep; ++rep) {
            int lofs = 0; asm volatile("" : "+s"(lofs));
            run_step(p, s, smem + lofs);
            if (COOP) { if (s + 1 < s1 || rep + 1 < nrep) { if (s0 < 0) cg::this_grid().sync(); else xcd_barrier(xb); } }
            else __syncthreads();
        }
    }
}

extern "C" void kernel_launch(void* const* d_in, const int* in_sizes, int n_in, void* d_out, int out_size, void* d_ws, size_t ws_size, hipStream_t stream) {
    static int grid = 0;
    if (grid == 0) {
        if (n_in != 17 || ws_size < WS_NEED || out_size != T_TOK * 1024) { fprintf(stderr, "kernel_launch: unexpected shapes (n_in %d ws %zu out %d)\n", n_in, ws_size, out_size); grid = -1; return; }
        int dev = 0, cus = 0, per_cu = 0;
        hipGetDevice(&dev); hipDeviceGetAttribute(&cus, hipDeviceAttributeMultiprocessorCount, dev);
        hipFuncSetAttribute((const void*)mega<true>, hipFuncAttributeMaxDynamicSharedMemorySize, LDS_BYTES);
        hipFuncSetAttribute((const void*)mega<false>, hipFuncAttributeMaxDynamicSharedMemorySize, LDS_BYTES);
        hipOccupancyMaxActiveBlocksPerMultiprocessor(&per_cu, (const void*)mega<true>, 512, LDS_BYTES);
        if (per_cu < 1) { fprintf(stderr, "kernel_launch: occupancy query says %d blocks/CU\n", per_cu); per_cu = 1; }
        (void)hipGetLastError();
        grid = cus;
    }
    if (grid < 0) return;
    Params p{};
    p.xp = (const float*)d_in[0]; p.xs = (const float*)d_in[1]; p.w_in = (const float*)d_in[2]; p.rpb = (const float*)d_in[3]; p.gconv = (const float*)d_in[4];
    p.a_log = (const float*)d_in[5]; p.dt_bias = (const float*)d_in[6]; p.gnorm = (const float*)d_in[7]; p.w_out = (const float*)d_in[8]; p.ln1g = (const float*)d_in[9];
    p.ln1b = (const float*)d_in[10]; p.w_up = (const float*)d_in[11]; p.fconvw = (const float*)d_in[12]; p.fconvb = (const float*)d_in[13]; p.w_down = (const float*)d_in[14];
    p.ln2g = (const float*)d_in[15]; p.ln2b = (const float*)d_in[16]; p.out = (float*)d_out; p.ws = (unsigned char*)d_ws;
#if ONE_LAUNCH
    if (hipMemsetAsync((unsigned char*)d_ws + OFF_BAR, 0, XCD_BAR_WORDS * sizeof(unsigned), stream) != hipSuccess) { fprintf(stderr, "kernel_launch: memset of barrier words failed\n"); return; }
    int s0 = 0, s1 = N_STEPS;
    void* args[] = {&p, &s0, &s1};
    hipError_t e = hipLaunchCooperativeKernel((const void*)mega<true>, dim3(grid), dim3(512), args, LDS_BYTES, stream);
    if (e != hipSuccess) fprintf(stderr, "cooperative launch failed: %s (grid %d)\n", hipGetErrorString(e), grid);
#else
    for (int s = 0; s < N_STEPS; ++s) hipLaunchKernelGGL(mega<false>, dim3(grid), dim3(512), LDS_BYTES, stream, p, s, s + 1);
#endif
}
```
